# Optimizing an MI355X kernel written in HIP

```python
import jax, jax.numpy as jnp
from jax import lax
import numpy as np

D_MODEL = 1024
BATCH = 4
SEQ = 8192
DEPTH = 1

ATTN_WIDTH = D_MODEL // 2
HEAD_DIM = 64
N_HEADS = ATTN_WIDTH // HEAD_DIM
CONV_WIDTH_CH = D_MODEL - ATTN_WIDTH
CONV_GROUPS = CONV_WIDTH_CH // HEAD_DIM
CONV_KERNEL = 31
D_FF = 2816
Q_BLOCK = 128
N_SUBLAYERS = 3
MIX_IN = 3 * ATTN_WIDTH + 2 * CONV_WIDTH_CH
RMS_EPS = 1e-6
LN_EPS = 1e-5

kernel_name = "hybrid_stickbreak_conformer_macaron_block"


def rms_norm(x, g, eps=RMS_EPS):
    xf = x.astype(jnp.float32)
    y = xf * lax.rsqrt(jnp.mean(xf * xf, axis=-1, keepdims=True) + eps)
    return (y * g.astype(jnp.float32)).astype(x.dtype)


def layer_norm(x, g, b, eps=LN_EPS):
    xf = x.astype(jnp.float32)
    mu = jnp.mean(xf, axis=-1, keepdims=True)
    var = jnp.mean(jnp.square(xf - mu), axis=-1, keepdims=True)
    y = (xf - mu) * lax.rsqrt(var + eps)
    return (y * g.astype(jnp.float32) + b.astype(jnp.float32)).astype(x.dtype)


def modulate(h, shift, scale):
    return h * (1.0 + scale[:, None, :]) + shift[:, None, :]


def swiglu_ffn(h, w_in, w_out):
    gate, up = jnp.split(h @ w_in, 2, axis=-1)
    return (jax.nn.silu(gate) * up) @ w_out


def stick_breaking_attention(q, k, v):
    seq = q.shape[2]
    scale = HEAD_DIM ** -0.5
    qf = q.astype(jnp.float32) * scale
    kf = k.astype(jnp.float32)
    vf = v.astype(jnp.float32)
    outs = []
    for start in range(0, seq, Q_BLOCK):
        end = start + Q_BLOCK
        q_blk = qf[:, :, start:end]
        k_ctx = kf[:, :, :end]
        v_ctx = vf[:, :, :end]
        z = jnp.einsum('bhqd,bhkd->bhqk', q_blk, k_ctx)
        q_pos = jnp.arange(start, end)[:, None]
        k_pos = jnp.arange(end)[None, :]
        strict = k_pos < q_pos
        log_one_minus = jnp.where(strict, jax.nn.log_sigmoid(-z), 0.0)
        after = lax.cumsum(log_one_minus, axis=3, reverse=True) - log_one_minus
        log_w = jax.nn.log_sigmoid(z) + after
        w = jnp.where(strict, jnp.exp(log_w), 0.0)
        outs.append(jnp.einsum('bhqk,bhkd->bhqd', w, v_ctx))
    return jnp.concatenate(outs, axis=2).astype(q.dtype)


def causal_depthwise_conv(u, w, b):
    y = lax.conv_general_dilated(
        u, w[:, None, :].astype(u.dtype), window_strides=(1,),
        padding=[(CONV_KERNEL - 1, 0)],
        dimension_numbers=('NWC', 'WIO', 'NWC'),
        feature_group_count=u.shape[-1])
    return y + b


def hybrid_mixer(h, w_in_mix, g_attn_out, conv_w, conv_b, conv_ln_g, conv_ln_b, w_out_mix):
    bsz, seq, _ = h.shape
    proj = h @ w_in_mix
    q, k, v, cv, cg = jnp.split(
        proj, [ATTN_WIDTH, 2 * ATTN_WIDTH, 3 * ATTN_WIDTH, 3 * ATTN_WIDTH + CONV_WIDTH_CH], axis=-1)

    def heads(t):
        return t.reshape(bsz, seq, N_HEADS, HEAD_DIM).transpose(0, 2, 1, 3)

    a = stick_breaking_attention(heads(q), heads(k), heads(v))
    a = rms_norm(a, g_attn_out[:, None, :])
    a = a.transpose(0, 2, 1, 3).reshape(bsz, seq, ATTN_WIDTH)

    u = cv * jax.nn.sigmoid(cg)
    u = causal_depthwise_conv(u, conv_w, conv_b)
    u = jax.nn.silu(layer_norm(u, conv_ln_g, conv_ln_b))

    return jnp.concatenate([a, u], axis=-1) @ w_out_mix


def sandwich_sublayer(x, g_pre, g_post, shift, scale, gate, res_w, fn):
    h = modulate(rms_norm(x, g_pre), shift, scale)
    y = rms_norm(fn(h), g_post)
    return x + res_w * (1.0 + gate[:, None, :]) * y


def setup_inputs(seed: int = 0) -> dict:
    key = jax.random.key(seed)
    ks = jax.random.split(key, 24)
    f32 = jnp.float32

    def nrm(k, shape, s):
        return jax.random.normal(k, shape, f32) * s

    def gain(k, n):
        return 1.0 + 0.02 * jax.random.normal(k, (n,), f32)

    return {
        "x": jax.random.normal(ks[0], (BATCH, SEQ, D_MODEL), f32),
        "c": jax.random.normal(ks[1], (BATCH, D_MODEL), f32),
        "w_ada": nrm(ks[2], (D_MODEL, 3 * N_SUBLAYERS * D_MODEL), 0.1 * D_MODEL ** -0.5),
        "b_ada": nrm(ks[3], (3 * N_SUBLAYERS * D_MODEL,), 0.02),
        "g_pre_ff1": gain(ks[4], D_MODEL),
        "g_post_ff1": gain(ks[5], D_MODEL),
        "ff1_w_in": nrm(ks[6], (D_MODEL, 2 * D_FF), D_MODEL ** -0.5),
        "ff1_w_out": nrm(ks[7], (D_FF, D_MODEL), D_FF ** -0.5),
        "g_pre_mix": gain(ks[8], D_MODEL),
        "g_post_mix": gain(ks[9], D_MODEL),
        "w_in_mix": nrm(ks[10], (D_MODEL, MIX_IN), D_MODEL ** -0.5),
        "g_attn_out": 1.0 + 0.02 * jax.random.normal(ks[11], (N_HEADS, HEAD_DIM), f32),
        "conv_w": nrm(ks[12], (CONV_KERNEL, CONV_WIDTH_CH), CONV_KERNEL ** -0.5),
        "conv_b": nrm(ks[13], (CONV_WIDTH_CH,), 0.02),
        "conv_ln_g": gain(ks[14], CONV_WIDTH_CH),
        "conv_ln_b": nrm(ks[15], (CONV_WIDTH_CH,), 0.02),
        "w_out_mix": nrm(ks[16], (D_MODEL, D_MODEL), D_MODEL ** -0.5),
        "g_pre_ff2": gain(ks[17], D_MODEL),
        "g_post_ff2": gain(ks[18], D_MODEL),
        "ff2_w_in": nrm(ks[19], (D_MODEL, 2 * D_FF), D_MODEL ** -0.5),
        "ff2_w_out": nrm(ks[20], (D_FF, D_MODEL), D_FF ** -0.5),
    }


def reference(x, c, w_ada, b_ada, g_pre_ff1, g_post_ff1, ff1_w_in, ff1_w_out,
              g_pre_mix, g_post_mix, w_in_mix, g_attn_out, conv_w, conv_b,
              conv_ln_g, conv_ln_b, w_out_mix, g_pre_ff2, g_post_ff2,
              ff2_w_in, ff2_w_out):
    mod = (jax.nn.silu(c) @ w_ada + b_ada).reshape(c.shape[0], N_SUBLAYERS, 3, D_MODEL)
    h = x
    for _layer in range(DEPTH):
        h = sandwich_sublayer(
            h, g_pre_ff1, g_post_ff1, mod[:, 0, 0], mod[:, 0, 1], mod[:, 0, 2], 0.5,
            lambda t: swiglu_ffn(t, ff1_w_in, ff1_w_out))
        h = sandwich_sublayer(
            h, g_pre_mix, g_post_mix, mod[:, 1, 0], mod[:, 1, 1], mod[:, 1, 2], 1.0,
            lambda t: hybrid_mixer(t, w_in_mix, g_attn_out, conv_w, conv_b,
                                   conv_ln_g, conv_ln_b, w_out_mix))
        h = sandwich_sublayer(
            h, g_pre_ff2, g_post_ff2, mod[:, 2, 0], mod[:, 2, 1], mod[:, 2, 2], 0.5,
            lambda t: swiglu_ffn(t, ff2_w_in, ff2_w_out))
    return h
```

```cpp
#include <hip/hip_runtime.h>
#include <hip/hip_cooperative_groups.h>
#include <cstdio>
#include <cstdint>
namespace cg = cooperative_groups;
namespace pg8 {
#define PG8_LAS __attribute__((address_space(3)))
typedef unsigned short bf16_t;
typedef short bf16x8 __attribute__((ext_vector_type(8)));
typedef float f32x4 __attribute__((ext_vector_type(4)));
typedef unsigned u32x4 __attribute__((ext_vector_type(4)));
constexpr int BM = 256, BK = 64, HALF = 128, HTB = HALF * BK * 2  , STAGE_BYTES = 8 * HTB, NXCD = 8, WGM = 8;

__host__ __device__ __forceinline__ int lds_byte(int r, int c) { const int st = (r >> 4) * 2 + (c >> 5), rr = r & 15, cc = c & 31, ob = rr * 64 + cc * 2; return st * 1024 + (ob ^ (((ob >> 9) & 1) << 5)); }
__host__ __device__ __forceinline__ void stage_rc(int b, int& R, int& C) { const int st = b / 1024, sb = b % 1024, swz = sb ^ (((sb >> 9) & 1) << 5); R = (st >> 1) * 16 + swz / 64; C = (st & 1) * 32 + (swz % 64) / 2; }
__host__ __device__ __forceinline__ int perm32(int rho) { const int n = rho >> 4, i = rho & 15; return 8 * (i >> 2) + 4 * n + (i & 3); }

struct Unit { int pm, pn; };
struct Gemm { const bf16_t* A; const bf16_t* Bt; int M, N, K; };

struct StaticOrder {
    int nM, nN, nwg, G, c;
    __host__ __device__ void init(int M, int N, int G_, int c_) { nM = M / BM; nN = N / BM; nwg = nM * nN; G = G_; c = c_; }
    __host__ __device__ bool next(int i, Unit& u) const {
        const long L = (long)i * G + c; if (L >= nwg) return false;
        int wgid = (int)L; { const int q = nwg / NXCD, r = nwg % NXCD, xcd = wgid % NXCD, off = wgid / NXCD; wgid = (xcd < r ? xcd * (q + 1) : r * (q + 1) + (xcd - r) * q) + off; }
        const int nig = WGM * nN, gid = wgid / nig, fm = gid * WGM, gsz = (nM - fm) < WGM ? (nM - fm) : WGM;
        u.pm = fm + ((wgid % nig) % gsz); u.pn = (wgid % nig) / gsz; return true;
    }
    __device__ __forceinline__ void a_ready(const Unit&) const {}
    __device__ __forceinline__ void done(const Unit&) const {}
};

__device__ __forceinline__ unsigned cvt_pk_bf16(float lo, float hi) { unsigned r; asm volatile("v_cvt_pk_bf16_f32 %0, %1, %2" : "=v"(r) : "v"(lo), "v"(hi)); return r; }
typedef float f32x2 __attribute__((ext_vector_type(2)));
__device__ __forceinline__ float fast_sigmoid(float v) { return __builtin_amdgcn_rcpf(1.0f + __builtin_amdgcn_exp2f(-1.4426950408889634f * v)); }
struct EpiPlain {
    static constexpr bool PERM = true, AFTER_DRAIN = false;
    bf16_t* O; int ldc; float scale;
    __device__ __forceinline__ void operator()(const f32x4 (&acc)[2][2][4][2], const Unit& u, int wr, int wc, int fr, int fq) const {
        const int row0 = u.pm * BM + wr * 64 + fr, col0 = u.pn * BM + wc * 32 + 8 * fq;
#pragma unroll
        for (int ai = 0; ai < 2; ++ai)
#pragma unroll
            for (int m = 0; m < 4; ++m) { bf16_t* rowp = O + (size_t)(row0 + ai * HALF + m * 16) * ldc + col0;
#pragma unroll
                for (int bj = 0; bj < 2; ++bj) { const f32x4 v0 = acc[ai][bj][m][0] * scale, v1 = acc[ai][bj][m][1] * scale;
                    u32x4 w; w.x = cvt_pk_bf16(v0[0], v0[1]); w.y = cvt_pk_bf16(v0[2], v0[3]); w.z = cvt_pk_bf16(v1[0], v1[1]); w.w = cvt_pk_bf16(v1[2], v1[3]);
                    *(u32x4*)(rowp + bj * HALF) = w; } }
    }
};
struct EpiSwiGLU {
    static constexpr bool PERM = true, AFTER_DRAIN = false;
    bf16_t* O; int ldc;
    __device__ __forceinline__ void operator()(const f32x4 (&acc)[2][2][4][2], const Unit& u, int wr, int wc, int fr, int fq) const {
        const int row0 = u.pm * BM + wr * 64 + fr, col0 = u.pn * HALF + wc * 32 + 8 * fq;
#pragma unroll
        for (int ai = 0; ai < 2; ++ai)
#pragma unroll
            for (int m = 0; m < 4; ++m) { bf16_t* rowp = O + (size_t)(row0 + ai * HALF + m * 16) * ldc + col0;
                f32x4 r[2];
#pragma unroll
                for (int n = 0; n < 2; ++n) { const f32x4 g = acc[ai][0][m][n], up = acc[ai][1][m][n];
#pragma unroll
                    for (int e = 0; e < 4; ++e) r[n][e] = g[e] * fast_sigmoid(g[e]) * up[e]; }
                u32x4 w; w.x = cvt_pk_bf16(r[0][0], r[0][1]); w.y = cvt_pk_bf16(r[0][2], r[0][3]); w.z = cvt_pk_bf16(r[1][0], r[1][1]); w.w = cvt_pk_bf16(r[1][2], r[1][3]);
                *(u32x4*)rowp = w; }
    }
};
struct EpiMix {
    static constexpr bool PERM = true, AFTER_DRAIN = false;
    bf16_t *Q, *Kb, *U;
    __device__ __forceinline__ void operator()(const f32x4 (&acc)[2][2][4][2], const Unit& u, int wr, int wc, int fr, int fq) const {
        const int row0 = u.pm * BM + wr * 64 + fr;
        if (u.pn < 4) {
            bf16_t* base = (u.pn < 2) ? Q : Kb; const float sc = (u.pn < 2) ? 0.125f : 1.0f; const int col0 = (u.pn & 1) * BM + wc * 32 + 8 * fq;
#pragma unroll
            for (int ai = 0; ai < 2; ++ai)
#pragma unroll
                for (int m = 0; m < 4; ++m) { bf16_t* rowp = base + (size_t)(row0 + ai * HALF + m * 16) * 512 + col0;
#pragma unroll
                    for (int bj = 0; bj < 2; ++bj) { const f32x4 v0 = acc[ai][bj][m][0] * sc, v1 = acc[ai][bj][m][1] * sc;
                        u32x4 w; w.x = cvt_pk_bf16(v0[0], v0[1]); w.y = cvt_pk_bf16(v0[2], v0[3]); w.z = cvt_pk_bf16(v1[0], v1[1]); w.w = cvt_pk_bf16(v1[2], v1[3]);
                        *(u32x4*)(rowp + bj * HALF) = w; } }
        } else {
            const int col0 = (u.pn - 4) * HALF + wc * 32 + 8 * fq;
#pragma unroll
            for (int ai = 0; ai < 2; ++ai)
#pragma unroll
                for (int m = 0; m < 4; ++m) { bf16_t* rowp = U + (size_t)(row0 + ai * HALF + m * 16) * 512 + col0;
                    f32x4 r[2];
#pragma unroll
                    for (int n = 0; n < 2; ++n) { const f32x4 cv = acc[ai][0][m][n], cgt = acc[ai][1][m][n];
#pragma unroll
                        for (int e = 0; e < 4; ++e) r[n][e] = cv[e] * fast_sigmoid(cgt[e]); }
                    u32x4 w; w.x = cvt_pk_bf16(r[0][0], r[0][1]); w.y = cvt_pk_bf16(r[0][2], r[0][3]); w.z = cvt_pk_bf16(r[1][0], r[1][1]); w.w = cvt_pk_bf16(r[1][2], r[1][3]);
                    *(u32x4*)rowp = w; }
        }
    }
};
template <class Epi, class Sched, bool ALIGN_EPI = false, bool SP2 = false>
__device__ __forceinline__ void gemm_phase(PG8_LAS unsigned char* lds, const Gemm g, const Sched& S, const Epi& E) {
    int tid_ = threadIdx.x; asm volatile("" : "+v"(tid_));
    const int tid = tid_, wid = __builtin_amdgcn_readfirstlane(tid >> 6), lane = tid & 63, wr = wid >> 2, wc = wid & 3, fr = lane & 15, fq = lane >> 4;
    const int K = g.K, nt = K / BK;
    unsigned voffA[2], voffB[2];
#pragma unroll
    for (int i = 0; i < 2; ++i) { int R, C; stage_rc(tid * 16 + i * 8192, R, C); const int Rb = Epi::PERM ? ((R & ~31) + perm32(R & 31)) : R;
        voffA[i] = (unsigned)(R * K + C) * 2u; voffB[i] = (unsigned)(Rb * K + C) * 2u; }
    const size_t kstep = (size_t)(BK * 2);
    const size_t hstep = (size_t)HALF * K * 2;
    const size_t tstep = 2 * hstep;
    const unsigned ldsw = (unsigned)wid * 1024u;
    const int aoff = lds_byte(wr * 64 + fr, fq * 8), boff = lds_byte(wc * 32 + fr, fq * 8);
#define PG8_SA(b, h) (((b) * 2 + (h)) * HTB)
#define PG8_SB(b, h) ((4 + (b) * 2 + (h)) * HTB)
#define PG8_STAGE(bufoff, gbase, voff) do { _Pragma("unroll") for (int _i = 0; _i < 2; ++_i) \
        __builtin_amdgcn_global_load_lds((const unsigned*)((const char*)(gbase) + (voff)[_i]), (PG8_LAS unsigned*)(lds + (bufoff) + ldsw + _i * 8192), 16, 0, 0); } while (0)
#define PG8_LDA(dst, b, h) do { _Pragma("unroll") for (int m = 0; m < 4; ++m) _Pragma("unroll") for (int k = 0; k < 2; ++k) dst[m][k] = *(const PG8_LAS bf16x8*)(lds + PG8_SA(b, h) + aoff + m * 2048 + k * 1024); } while (0)
#define PG8_LDB(dst, b, h) do { _Pragma("unroll") for (int n = 0; n < 2; ++n) _Pragma("unroll") for (int k = 0; k < 2; ++k) dst[n][k] = *(const PG8_LAS bf16x8*)(lds + PG8_SB(b, h) + boff + n * 2048 + k * 1024); } while (0)
#define PG8_MMA(ai, bj, At, Bt) do { __builtin_amdgcn_s_setprio(1); _Pragma("unroll") for (int m = 0; m < 4; ++m) _Pragma("unroll") for (int n = 0; n < 2; ++n) _Pragma("unroll") for (int k = 0; k < 2; ++k) \
        acc[ai][bj][m][n] = __builtin_amdgcn_mfma_f32_16x16x32_bf16(Bt[n][k], At[m][k], acc[ai][bj][m][n], 0, 0, 0); __builtin_amdgcn_s_setprio(0); } while (0)
#define PG8_WAIT_V(n) asm volatile("s_waitcnt vmcnt(" #n ")" ::: "memory")
#define PG8_WAIT_L(n) asm volatile("s_waitcnt lgkmcnt(" #n ")" ::: "memory")
#define PG8_BAR __builtin_amdgcn_s_barrier()
#define PG8_SCHED __builtin_amdgcn_sched_barrier(0)
    Unit cur, nxt; int ui = 0;
    if (!S.next(0, cur)) return;
    f32x4 acc[2][2][4][2];
#pragma unroll
    for (int a = 0; a < 2; ++a)
#pragma unroll
        for (int b = 0; b < 2; ++b)
#pragma unroll
            for (int m = 0; m < 4; ++m)
#pragma unroll
                for (int n = 0; n < 2; ++n) acc[a][b][m][n] = (f32x4){0.f, 0.f, 0.f, 0.f};
    bf16x8 At[4][2], B0[2][2], B1[2][2];
    const char* cA = (const char*)g.A + (size_t)cur.pm * tstep; const char* cB = (const char*)g.Bt + (size_t)cur.pn * tstep;
    S.a_ready(cur);
    if constexpr (SP2) {
        PG8_STAGE(PG8_SB(0, 0), cB, voffB); PG8_STAGE(PG8_SB(0, 1), cB + hstep, voffB); PG8_STAGE(PG8_SA(0, 0), cA, voffA); PG8_STAGE(PG8_SA(0, 1), cA + hstep, voffA);
        if (wr == 1) PG8_BAR;
        PG8_WAIT_V(2); PG8_BAR;
        PG8_STAGE(PG8_SB(1, 0), cB + kstep, voffB); PG8_STAGE(PG8_SA(1, 0), cA + kstep, voffA); PG8_STAGE(PG8_SB(1, 1), cB + hstep + kstep, voffB);
        PG8_WAIT_V(6); PG8_BAR;
    } else {
        PG8_STAGE(PG8_SB(0, 0), cB, voffB); PG8_STAGE(PG8_SA(0, 0), cA, voffA); PG8_STAGE(PG8_SB(0, 1), cB + hstep, voffB); PG8_STAGE(PG8_SA(0, 1), cA + hstep, voffA);
        if (wr == 1) PG8_BAR;
        PG8_WAIT_V(4); PG8_BAR;
        PG8_STAGE(PG8_SB(1, 0), cB + kstep, voffB); PG8_STAGE(PG8_SA(1, 0), cA + kstep, voffA); PG8_STAGE(PG8_SB(1, 1), cB + hstep + kstep, voffB);
        PG8_WAIT_V(6); PG8_BAR;
    }
    for (;;) {
        const bool has_next = S.next(ui + 1, nxt);
        const char* nA = has_next ? (const char*)g.A + (size_t)nxt.pm * tstep : cA; const char* nB = has_next ? (const char*)g.Bt + (size_t)nxt.pn * tstep : cB;
        for (int t = 0; t < nt; t += 2) {
            const bool last = (t == nt - 2);
            const char* a1 = cA + (size_t)(t + 1) * kstep;
            const char* a2 = last ? nA : cA + (size_t)(t + 2) * kstep; const char* b2 = last ? nB : cB + (size_t)(t + 2) * kstep;
            const char* a3 = a2 + kstep; const char* b3 = b2 + kstep;
            if (last && has_next) S.a_ready(nxt);
            if constexpr (SP2) {
            PG8_LDB(B0, 0, 0); PG8_LDB(B1, 0, 1); PG8_SCHED; PG8_LDA(At, 0, 0); PG8_STAGE(PG8_SA(1, 1), a1 + hstep, voffA);
            PG8_WAIT_V(8); PG8_WAIT_L(0); PG8_BAR; PG8_MMA(0, 0, At, B0); PG8_MMA(0, 1, At, B1); PG8_BAR; PG8_SCHED;
            PG8_LDA(At, 0, 1); PG8_STAGE(PG8_SB(0, 0), b2, voffB); PG8_STAGE(PG8_SB(0, 1), b2 + hstep, voffB); PG8_STAGE(PG8_SA(0, 0), a2, voffA);
            PG8_WAIT_V(8); PG8_WAIT_L(0); PG8_BAR; PG8_MMA(1, 0, At, B0); PG8_MMA(1, 1, At, B1); PG8_BAR; PG8_SCHED;
            PG8_LDB(B0, 1, 0); PG8_LDB(B1, 1, 1); PG8_SCHED; PG8_LDA(At, 1, 0); PG8_STAGE(PG8_SA(0, 1), a2 + hstep, voffA);
            PG8_WAIT_V(8); PG8_WAIT_L(0); PG8_BAR; PG8_MMA(0, 0, At, B0); PG8_MMA(0, 1, At, B1); PG8_BAR; PG8_SCHED;
            PG8_LDA(At, 1, 1); PG8_STAGE(PG8_SB(1, 0), b3, voffB); PG8_STAGE(PG8_SB(1, 1), b3 + hstep, voffB); PG8_STAGE(PG8_SA(1, 0), a3, voffA);
            PG8_WAIT_V(8); PG8_WAIT_L(0); PG8_BAR; PG8_MMA(1, 0, At, B0); PG8_MMA(1, 1, At, B1); PG8_BAR; PG8_SCHED;
            } else {
            PG8_LDB(B0, 0, 0); PG8_SCHED; PG8_LDA(At, 0, 0); PG8_STAGE(PG8_SA(1, 1), a1 + hstep, voffA);
            PG8_WAIT_L(8); PG8_BAR; PG8_WAIT_L(0); PG8_MMA(0, 0, At, B0); PG8_BAR; PG8_SCHED;
            PG8_LDB(B1, 0, 1); PG8_STAGE(PG8_SB(0, 0), b2, voffB);
            PG8_BAR; PG8_WAIT_L(0); PG8_MMA(0, 1, At, B1); PG8_BAR;
            PG8_LDA(At, 0, 1); PG8_STAGE(PG8_SA(0, 0), a2, voffA);
            PG8_BAR; PG8_WAIT_L(0); PG8_MMA(1, 0, At, B0); PG8_BAR; PG8_SCHED;
            PG8_STAGE(PG8_SB(0, 1), b2 + hstep, voffB);
            PG8_WAIT_V(6); PG8_BAR; PG8_MMA(1, 1, At, B1); PG8_BAR;
            PG8_LDB(B0, 1, 0); PG8_SCHED; PG8_LDA(At, 1, 0); PG8_STAGE(PG8_SA(0, 1), a2 + hstep, voffA);
            PG8_WAIT_L(8); PG8_BAR; PG8_WAIT_L(0); PG8_MMA(0, 0, At, B0); PG8_BAR; PG8_SCHED;
            PG8_LDB(B1, 1, 1); PG8_STAGE(PG8_SB(1, 0), b3, voffB);
            PG8_BAR; PG8_WAIT_L(0); PG8_MMA(0, 1, At, B1); PG8_BAR;
            PG8_LDA(At, 1, 1); PG8_STAGE(PG8_SA(1, 0), a3, voffA);
            PG8_BAR; PG8_WAIT_L(0); PG8_MMA(1, 0, At, B0); PG8_BAR; PG8_SCHED;
            PG8_STAGE(PG8_SB(1, 1), b3 + hstep, voffB);
            PG8_WAIT_V(6); PG8_BAR; PG8_MMA(1, 1, At, B1); PG8_BAR;
            }
        }
        if constexpr (ALIGN_EPI) { if (wr == 0) PG8_BAR; }
        if constexpr (!Epi::AFTER_DRAIN) { E(acc, cur, wr, wc, fr, fq); S.done(cur); }
        if (!has_next) break;
#pragma unroll
        for (int a = 0; a < 2; ++a)
#pragma unroll
            for (int b = 0; b < 2; ++b)
#pragma unroll
                for (int m = 0; m < 4; ++m)
#pragma unroll
                    for (int n = 0; n < 2; ++n) acc[a][b][m][n] = (f32x4){0.f, 0.f, 0.f, 0.f};
        cur = nxt; cA = nA; cB = nB; ++ui;
        if constexpr (ALIGN_EPI) { if (wr == 1) PG8_BAR; }
    }
    PG8_WAIT_V(0);
    if constexpr (!ALIGN_EPI) { if (wr == 0) PG8_BAR; }
    PG8_BAR;
    if constexpr (Epi::AFTER_DRAIN) { E.fused(acc, cur, wr, wc, fr, fq, lds, wid, lane); S.done(cur); }
#undef PG8_SA
#undef PG8_SB
#undef PG8_STAGE
#undef PG8_LDA
#undef PG8_LDB
#undef PG8_MMA
#undef PG8_WAIT_V
#undef PG8_WAIT_L
#undef PG8_BAR
#undef PG8_SCHED
}
}

constexpr int BATCH = 4, SEQ = 8192, D = 1024, M = BATCH * SEQ, DFF = 2816, AW = 512, NHEAD = 8, HD = 64, CK = 31, NMOD = 9 * D;
constexpr float RMS_EPS = 1e-6f, LN_EPS = 1e-5f;
constexpr int NWAVES = 8, NTHREADS = 512;
constexpr int LDS_BYTES = 147456;
constexpr int KCH = 16;
constexpr float STICK_EXIT = -110.0f;

constexpr size_t MiB = 1u << 20;
constexpr size_t WS_CTL = 0, WS_PART = 1 * MiB, WS_MODTAB = 4 * MiB;
constexpr size_t WS_W1IN = 8 * MiB, WS_W1OUT = 19 * MiB, WS_WMIXA = 25 * MiB, WS_WMIXV = 29 * MiB, WS_WMO = 30 * MiB, WS_W2IN = 32 * MiB, WS_W2OUT = 43 * MiB;
constexpr size_t WS_H = 64 * MiB, WS_Y = 128 * MiB, WS_ACT = 192 * MiB, WS_Q = 192 * MiB, WS_K = 224 * MiB, WS_VT = 256 * MiB, WS_U = 288 * MiB, WS_CAT = 368 * MiB, WS_END = 432 * MiB;

#define LAS __attribute__((address_space(3)))
typedef unsigned short bf16;
typedef float f32x4 __attribute__((ext_vector_type(4)));
typedef float f32x16 __attribute__((ext_vector_type(16)));
typedef short bf16x8 __attribute__((ext_vector_type(8)));
typedef short s16x4 __attribute__((ext_vector_type(4)));
typedef unsigned u32x2 __attribute__((ext_vector_type(2)));
typedef unsigned u32x4 __attribute__((ext_vector_type(4)));
typedef float f32x2_t __attribute__((ext_vector_type(2)));
typedef __bf16 bf16x2_t __attribute__((ext_vector_type(2)));
#define LDS_WAIT() asm volatile("s_waitcnt lgkmcnt(0)" ::: "memory")

__device__ __forceinline__ unsigned pk2(float lo, float hi) { f32x2_t v = {lo, hi}; bf16x2_t b = __builtin_convertvector(v, bf16x2_t); return __builtin_bit_cast(unsigned, b); }
__device__ __forceinline__ float bf_lo(unsigned u) { return __uint_as_float(u << 16); }
__device__ __forceinline__ float bf_hi(unsigned u) { return __uint_as_float(u & 0xffff0000u); }
__device__ __forceinline__ float wave_sum(float v) {
#pragma unroll
    for (int o = 1; o < 64; o <<= 1) v += __shfl_xor(v, o);
    return v;
}
__device__ __forceinline__ float rdlane(float v, int l) { return __uint_as_float((unsigned)__builtin_amdgcn_readlane((int)__float_as_uint(v), l)); }

__device__ __forceinline__ void tr_item(const float* __restrict__ W, int K, int N, bf16* dst, LAS float* scr, int k0, int n0, int lane) {
#pragma unroll 8
    for (int i = 0; i < 32; ++i) { const int kk = 2 * i + (lane >> 5); scr[kk * 33 + (lane & 31)] = W[(size_t)(k0 + kk) * N + n0 + (lane & 31)]; }
    LDS_WAIT(); asm volatile("" ::: "memory");
    const int c = lane & 7;
#pragma unroll
    for (int j = 0; j < 4; ++j) { const int n = (lane >> 3) + 8 * j; const LAS float* s = scr + (8 * c) * 33 + n;
        u32x4 o; o.x = pk2(s[0 * 33], s[1 * 33]); o.y = pk2(s[2 * 33], s[3 * 33]); o.z = pk2(s[4 * 33], s[5 * 33]); o.w = pk2(s[6 * 33], s[7 * 33]);
        *(u32x4*)(dst + (size_t)n * K + k0 + 8 * c) = o; }
    LDS_WAIT(); asm volatile("" ::: "memory");
}
__device__ __forceinline__ int ffin_row(int n0) { const int bj = n0 / DFF, c = n0 % DFF; return 256 * (c / 128) + 128 * bj + (c % 128); }
__device__ __forceinline__ void tr_matrix(int mat, int r, const float* const* in, unsigned char* ws, LAS float* scr, int lane) {
    if (mat == 0 || mat == 4) {
        const int nblk = 2 * DFF / 32, kb = r / nblk, nb = r % nblk, n0 = 32 * nb;
        bf16* dst = (bf16*)(ws + (mat == 0 ? WS_W1IN : WS_W2IN)) + (size_t)ffin_row(n0) * D;
        tr_item(in[mat == 0 ? 6 : 19], D, 2 * DFF, dst, scr, 64 * kb, n0, lane);
    } else if (mat == 1 || mat == 5) {
        const int nblk = D / 32, kb = r / nblk, nb = r % nblk, n0 = 32 * nb;
        bf16* dst = (bf16*)(ws + (mat == 1 ? WS_W1OUT : WS_W2OUT)) + (size_t)n0 * DFF;
        tr_item(in[mat == 1 ? 7 : 20], DFF, D, dst, scr, 64 * kb, n0, lane);
    } else if (mat == 2) {
        const int nblk = 2560 / 32, kb = r / nblk, nb = r % nblk, n0 = 32 * nb;
        bf16* dst;
        if (n0 < 1024) dst = (bf16*)(ws + WS_WMIXA) + (size_t)n0 * D;
        else if (n0 < 1536) dst = (bf16*)(ws + WS_WMIXV) + (size_t)(n0 - 1024) * D;
        else { const int c = n0 - 1536, bj = c / 512, cc = c % 512; dst = (bf16*)(ws + WS_WMIXA) + (size_t)(1024 + 256 * (cc / 128) + 128 * bj + (cc % 128)) * D; }
        tr_item(in[10], D, 2560, dst, scr, 64 * kb, n0, lane);
    } else {
        const int nblk = D / 32, kb = r / nblk, nb = r % nblk, n0 = 32 * nb;
        bf16* dst = (bf16*)(ws + WS_WMO) + (size_t)n0 * D;
        tr_item(in[16], D, D, dst, scr, 64 * kb, n0, lane);
    }
}
__device__ __forceinline__ void ada_item(int r, const float* __restrict__ cvec, const float* __restrict__ w_ada, float* part, int lane) {
    const int cgp = r / KCH, kc = r % KCH, n = 64 * cgp + lane;
    float sc[4], acc[4];
#pragma unroll
    for (int b = 0; b < 4; ++b) { const float v = cvec[b * D + 64 * kc + lane]; sc[b] = v / (1.0f + __expf(-v)); acc[b] = 0.f; }
    const float* wp = w_ada + (size_t)(64 * kc) * NMOD + n;
#pragma unroll
    for (int kk = 0; kk < 64; ++kk) { const float w = wp[(size_t)kk * NMOD];
#pragma unroll
        for (int b = 0; b < 4; ++b) acc[b] += rdlane(sc[b], kk) * w; }
#pragma unroll
    for (int b = 0; b < 4; ++b) part[(size_t)(kc * 4 + b) * NMOD + n] = acc[b];
}
__device__ __forceinline__ void p0_prologue(const float* const* in, unsigned char* ws, LAS unsigned char* lds, int wave, int lane) {
    LAS float* scr = (LAS float*)(lds + wave * 16384);
    const int gw = blockIdx.x * NWAVES + wave, NGW = gridDim.x * NWAVES;
    constexpr int I_IN = (D / 64) * (2 * DFF / 32), I_OUT = (DFF / 64) * (D / 32), I_MIX = (D / 64) * (2560 / 32), I_MO = (D / 64) * (D / 32);
    constexpr int NTR = 2 * I_IN + 2 * I_OUT + I_MIX + I_MO, NADA = (NMOD / 64) * KCH;
    for (int it = gw; it < NTR + NADA; it += NGW) {
        int r = it;
        if (r < I_IN) { tr_matrix(0, r, in, ws, scr, lane); continue; } r -= I_IN;
        if (r < I_OUT) { tr_matrix(1, r, in, ws, scr, lane); continue; } r -= I_OUT;
        if (r < I_MIX) { tr_matrix(2, r, in, ws, scr, lane); continue; } r -= I_MIX;
        if (r < I_MO) { tr_matrix(3, r, in, ws, scr, lane); continue; } r -= I_MO;
        if (r < I_IN) { tr_matrix(4, r, in, ws, scr, lane); continue; } r -= I_IN;
        if (r < I_OUT) { tr_matrix(5, r, in, ws, scr, lane); continue; } r -= I_OUT;
#ifndef NO_ADA
        ada_item(r, in[1], in[2], (float*)(ws + WS_PART), lane);
#endif
    }
}

template <bool HAS_Y, bool HAS_H>
__device__ __forceinline__ void norm_pass(const float* xin, const bf16* y, float* xout, bf16* h, const float* gate, const float* gpost, float rw,
                                          const float* gpre, const float* scale, const float* shift, int rowbeg, int wave, int lane) {
    f32x4 A[4], B[4], C[4];
#pragma unroll
    for (int j = 0; j < 4; ++j) { const int c = 4 * lane + 256 * j;
        if (HAS_Y) { const f32x4 g = *(const f32x4*)(gate + c), gp = *(const f32x4*)(gpost + c); A[j] = (g + 1.0f) * gp * rw; }
        if (HAS_H) { const f32x4 s = *(const f32x4*)(scale + c), gp = *(const f32x4*)(gpre + c); B[j] = (s + 1.0f) * gp; C[j] = *(const f32x4*)(shift + c); } }
    for (int i = 0; i < 16; ++i) {
        const size_t row = (size_t)(rowbeg + wave * 16 + i);
        f32x4 x[4]; u32x2 yv[4];
#pragma unroll
        for (int j = 0; j < 4; ++j) x[j] = *(const f32x4*)(xin + row * D + 4 * lane + 256 * j);
        if (HAS_Y) {
#pragma unroll
            for (int j = 0; j < 4; ++j) yv[j] = *(const u32x2*)(y + row * D + 4 * lane + 256 * j);
            f32x4 yf[4]; float ss = 0.f;
#pragma unroll
            for (int j = 0; j < 4; ++j) { yf[j] = (f32x4){bf_lo(yv[j].x), bf_hi(yv[j].x), bf_lo(yv[j].y), bf_hi(yv[j].y)}; ss += (yf[j].x * yf[j].x + yf[j].y * yf[j].y) + (yf[j].z * yf[j].z + yf[j].w * yf[j].w); }
            const float r = 1.0f / sqrtf(wave_sum(ss) * (1.0f / D) + RMS_EPS);
#pragma unroll
            for (int j = 0; j < 4; ++j) { x[j] = x[j] + A[j] * yf[j] * r; *(f32x4*)(xout + row * D + 4 * lane + 256 * j) = x[j]; }
        }
        if (HAS_H) {
            float ss = 0.f;
#pragma unroll
            for (int j = 0; j < 4; ++j) ss += (x[j].x * x[j].x + x[j].y * x[j].y) + (x[j].z * x[j].z + x[j].w * x[j].w);
            const float r = 1.0f / sqrtf(wave_sum(ss) * (1.0f / D) + RMS_EPS);
#pragma unroll
            for (int j = 0; j < 4; ++j) { const f32x4 o = x[j] * r * B[j] + C[j]; u32x2 w; w.x = pk2(o.x, o.y); w.y = pk2(o.z, o.w); *(u32x2*)(h + row * D + 4 * lane + 256 * j) = w; }
        }
    }
}

__device__ __forceinline__ void conv_group(int grp, const bf16* U, bf16* cat, const LAS float* cw, const float* conv_b, const float* ln_g, const float* ln_b, int lane) {
    const int tok0 = grp * 4, s0 = tok0 % SEQ;
    float acc[4][8], ww[4][8];
#pragma unroll
    for (int i = 0; i < 4; ++i)
#pragma unroll
        for (int e = 0; e < 8; ++e) { acc[i][e] = 0.f; ww[i][e] = 0.f; }
    const bf16* up = U + (size_t)tok0 * AW + 8 * lane;
#pragma unroll 4
    for (int j = 0; j < 36; ++j) {
#pragma unroll
        for (int e = 0; e < 8; ++e) { ww[3][e] = ww[2][e]; ww[2][e] = ww[1][e]; ww[1][e] = ww[0][e]; }
        if (j < CK) { const f32x4 w0 = *(const LAS f32x4*)(cw + j * AW + 8 * lane), w1 = *(const LAS f32x4*)(cw + j * AW + 8 * lane + 4);
#pragma unroll
            for (int e = 0; e < 4; ++e) { ww[0][e] = w0[e]; ww[0][4 + e] = w1[e]; }
        } else {
#pragma unroll
            for (int e = 0; e < 8; ++e) ww[0][e] = 0.f; }
        float xr[8];
        if (s0 - 30 + j >= 0 && j < 34) { const u32x4 v = *(const u32x4*)(up + (ptrdiff_t)(j - 30) * AW);
            xr[0] = bf_lo(v.x); xr[1] = bf_hi(v.x); xr[2] = bf_lo(v.y); xr[3] = bf_hi(v.y); xr[4] = bf_lo(v.z); xr[5] = bf_hi(v.z); xr[6] = bf_lo(v.w); xr[7] = bf_hi(v.w);
        } else {
#pragma unroll
            for (int e = 0; e < 8; ++e) xr[e] = 0.f; }
#pragma unroll
        for (int i = 0; i < 4; ++i)
#pragma unroll
            for (int e = 0; e < 8; ++e) acc[i][e] += ww[i][e] * xr[e];
    }
    const f32x4 b0 = *(const f32x4*)(conv_b + 8 * lane), b1 = *(const f32x4*)(conv_b + 8 * lane + 4);
    const f32x4 g0 = *(const f32x4*)(ln_g + 8 * lane), g1 = *(const f32x4*)(ln_g + 8 * lane + 4);
    const f32x4 lb0 = *(const f32x4*)(ln_b + 8 * lane), lb1 = *(const f32x4*)(ln_b + 8 * lane + 4);
#pragma unroll
    for (int i = 0; i < 4; ++i) {
        float v[8]; float s = 0.f;
#pragma unroll
        for (int e = 0; e < 8; ++e) { v[e] = acc[i][e] + (e < 4 ? b0[e] : b1[e - 4]); s += v[e]; }
        const float mean = wave_sum(s) * (1.0f / AW); float q = 0.f;
#pragma unroll
        for (int e = 0; e < 8; ++e) { v[e] -= mean; q += v[e] * v[e]; }
        const float rstd = 1.0f / sqrtf(wave_sum(q) * (1.0f / AW) + LN_EPS);
        float o[8];
#pragma unroll
        for (int e = 0; e < 8; ++e) { const float t = v[e] * rstd * (e < 4 ? g0[e] : g1[e - 4]) + (e < 4 ? lb0[e] : lb1[e - 4]); o[e] = t * pg8::fast_sigmoid(t); }
        u32x4 w; w.x = pk2(o[0], o[1]); w.y = pk2(o[2], o[3]); w.z = pk2(o[4], o[5]); w.w = pk2(o[6], o[7]);
        *(u32x4*)(cat + (size_t)(tok0 + i) * D + AW + 8 * lane) = w;
    }
}

__device__ __forceinline__ int crow(int r, int hi) { return (r & 3) + 8 * (r >> 2) + 4 * hi; }
__device__ __forceinline__ void attn_unit(const bf16* __restrict__ Q, const bf16* __restrict__ K, const bf16* __restrict__ VT, bf16* cat, const float* __restrict__ g_attn, int b, int h, int qb, int lane) {
    const int r32 = lane & 31, hi = lane >> 5;
    const size_t rowbase = (size_t)b * SEQ;
    const int t0 = qb * 32;
    bf16x8 qf[4];
    { const bf16* qp = Q + (rowbase + t0 + r32) * AW + h * HD + 8 * hi;
#pragma unroll
      for (int d0 = 0; d0 < 4; ++d0) qf[d0] = *(const bf16x8*)(qp + 16 * d0); }
    f32x16 o0, o1;
#pragma unroll
    for (int r = 0; r < 16; ++r) { o0[r] = 0.f; o1[r] = 0.f; }
    float carry = 0.f;
    for (int kb = qb; kb >= 0; --kb) {
        const int s0 = kb * 32;
        const bf16* kp = K + (rowbase + s0 + r32) * AW + h * HD + 8 * hi;
        bf16x8 kf[4];
#pragma unroll
        for (int d0 = 0; d0 < 4; ++d0) kf[d0] = *(const bf16x8*)(kp + 16 * d0);
        const bf16* vp = VT + (size_t)(h * HD + r32) * M + rowbase + s0 + 4 * hi;
        s16x4 va[2][2][2];
#pragma unroll
        for (int db = 0; db < 2; ++db)
#pragma unroll
            for (int ks = 0; ks < 2; ++ks) { va[db][ks][0] = *(const s16x4*)(vp + (size_t)db * 32 * M + 16 * ks); va[db][ks][1] = *(const s16x4*)(vp + (size_t)db * 32 * M + 16 * ks + 8); }
        f32x16 p;
#pragma unroll
        for (int r = 0; r < 16; ++r) p[r] = 0.f;
#pragma unroll
        for (int d0 = 0; d0 < 4; ++d0) p = __builtin_amdgcn_mfma_f32_32x32x16_bf16(kf[d0], qf[d0], p, 0, 0, 0);
        const bool diag = (kb == qb);
        float L[16];
#pragma unroll
        for (int r = 0; r < 16; ++r) { const float z = p[r];
            const float sp = fmaxf(z, 0.f) + 0.6931471805599453f * __builtin_amdgcn_logf(1.0f + __builtin_amdgcn_exp2f(-1.4426950408889634f * fabsf(z)));
            const bool valid = !diag || (crow(r, hi) < r32);
            L[r] = valid ? -sp : 0.f; }
        float E[4], O[4];
#pragma unroll
        for (int c = 0; c < 4; ++c) { const float gs = (L[4 * c] + L[4 * c + 1]) + (L[4 * c + 2] + L[4 * c + 3]);
            auto rr = __builtin_amdgcn_permlane32_swap(__float_as_uint(gs), __float_as_uint(gs), false, false);
            E[c] = __uint_as_float(rr[0]); O[c] = __uint_as_float(rr[1]); }
        float T[4]; T[3] = 0.f; T[2] = E[3] + O[3]; T[1] = T[2] + (E[2] + O[2]); T[0] = T[1] + (E[1] + O[1]);
        const float total = T[0] + (E[0] + O[0]);
        float w[16];
#pragma unroll
        for (int c = 0; c < 4; ++c) {
            const float after = carry + T[c] + (hi == 0 ? O[c] : 0.f);
            const float s3 = L[4 * c + 3] + after, s2 = L[4 * c + 2] + s3, s1 = L[4 * c + 1] + s2, s0_ = L[4 * c] + s1;
            const float ss[4] = {s0_, s1, s2, s3};
#pragma unroll
            for (int i = 0; i < 4; ++i) { const int r = 4 * c + i; const bool valid = !diag || (crow(r, hi) < r32);
                const float e = __builtin_amdgcn_exp2f(1.4426950408889634f * (p[r] + ss[i]));
                w[r] = valid ? e : 0.f; }
        }
        carry += total;
#pragma unroll
        for (int ks = 0; ks < 2; ++ks) {
            u32x4 pw; pw.x = pk2(w[8 * ks], w[8 * ks + 1]); pw.y = pk2(w[8 * ks + 2], w[8 * ks + 3]); pw.z = pk2(w[8 * ks + 4], w[8 * ks + 5]); pw.w = pk2(w[8 * ks + 6], w[8 * ks + 7]);
            const bf16x8 pb = __builtin_bit_cast(bf16x8, pw);
            const bf16x8 a0 = __builtin_shufflevector(va[0][ks][0], va[0][ks][1], 0, 1, 2, 3, 4, 5, 6, 7);
            const bf16x8 a1 = __builtin_shufflevector(va[1][ks][0], va[1][ks][1], 0, 1, 2, 3, 4, 5, 6, 7);
            o0 = __builtin_amdgcn_mfma_f32_32x32x16_bf16(a0, pb, o0, 0, 0, 0);
            o1 = __builtin_amdgcn_mfma_f32_32x32x16_bf16(a1, pb, o1, 0, 0, 0);
        }
        if (__all(carry < STICK_EXIT)) break;
    }
    float ss = 0.f;
#pragma unroll
    for (int r = 0; r < 16; ++r) ss += o0[r] * o0[r] + o1[r] * o1[r];
    { auto rr = __builtin_amdgcn_permlane32_swap(__float_as_uint(ss), __float_as_uint(ss), false, false); ss = __uint_as_float(rr[0]) + __uint_as_float(rr[1]); }
    const float rstd = 1.0f / sqrtf(ss * (1.0f / HD) + RMS_EPS);
    bf16* op = cat + (rowbase + t0 + r32) * D + h * HD + 4 * hi;
    const float* gp = g_attn + h * HD + 4 * hi;
#pragma unroll
    for (int c = 0; c < 4; ++c) {
        const f32x4 ga = *(const f32x4*)(gp + 8 * c), gb = *(const f32x4*)(gp + 32 + 8 * c);
        u32x2 wa, wb;
        wa.x = pk2(o0[4 * c] * rstd * ga.x, o0[4 * c + 1] * rstd * ga.y); wa.y = pk2(o0[4 * c + 2] * rstd * ga.z, o0[4 * c + 3] * rstd * ga.w);
        wb.x = pk2(o1[4 * c] * rstd * gb.x, o1[4 * c + 1] * rstd * gb.y); wb.y = pk2(o1[4 * c + 2] * rstd * gb.z, o1[4 * c + 3] * rstd * gb.w);
        *(u32x2*)(op + 8 * c) = wa; *(u32x2*)(op + 32 + 8 * c) = wb;
    }
}

struct Args { const float* in[21]; float* out; unsigned char* ws; };
__global__ void __launch_bounds__(NTHREADS, 2) fwd_megakernel(Args args) {
    extern __shared__ __attribute__((aligned(16))) unsigned char lds_raw[];
    LAS unsigned char* lds = (LAS unsigned char*)lds_raw;
    cg::grid_group grid = cg::this_grid();
    const int tid = threadIdx.x, lane = tid & 63, wave = __builtin_amdgcn_readfirstlane(tid >> 6);
    const int G = gridDim.x, bid = blockIdx.x;
    unsigned char* ws = args.ws;
    const float* const* in = args.in;
    bf16* Hb = (bf16*)(ws + WS_H); bf16* Yb = (bf16*)(ws + WS_Y); bf16* ACT = (bf16*)(ws + WS_ACT);
    bf16* Qb = (bf16*)(ws + WS_Q); bf16* Kb = (bf16*)(ws + WS_K); bf16* VT = (bf16*)(ws + WS_VT); bf16* Ub = (bf16*)(ws + WS_U); bf16* CAT = (bf16*)(ws + WS_CAT);
    float* part = (float*)(ws + WS_PART); float* modtab = (float*)(ws + WS_MODTAB);
    const int rowbeg = bid * (M / 256), batch = rowbeg / SEQ;
#define GRID_BAR() grid.sync()
#define FRESH_LANE() ({ int l_ = lane; asm volatile("" : "+v"(l_)); l_; })
#define MODV(sub, j) (modtab + ((size_t)batch * 9 + (sub) * 3 + (j)) * D)

    p0_prologue(in, ws, lds, wave, FRESH_LANE());
    GRID_BAR();

    {
        if (tid < 36) { const int f4 = bid * 36 + tid;
            const int bb = f4 / (NMOD / 4), off = (f4 % (NMOD / 4)) * 4;
            f32x4 s = *(const f32x4*)(in[3] + off);
#pragma unroll
            for (int kc = 0; kc < KCH; ++kc) s = s + *(const f32x4*)(part + (size_t)(kc * 4 + bb) * NMOD + off);
            *(f32x4*)(modtab + (size_t)bb * NMOD + off) = s; }
        LAS float* ml = (LAS float*)lds;
        { const int off = tid * 4; f32x4 s = *(const f32x4*)(in[3] + off);
#pragma unroll
          for (int kc = 0; kc < KCH; ++kc) s = s + *(const f32x4*)(part + (size_t)(kc * 4 + batch) * NMOD + off);
          *(LAS f32x4*)(ml + off) = s; }
        __syncthreads();
        norm_pass<false, true>(in[0], nullptr, nullptr, Hb, nullptr, nullptr, 0.f, in[4], (const float*)(ml + D), (const float*)ml, rowbeg, wave, FRESH_LANE());
    }
    GRID_BAR();

    { pg8::Gemm g{Hb, (const bf16*)(ws + WS_W1IN), M, 2 * DFF, D}; pg8::StaticOrder S; S.init(M, 2 * DFF, G, bid);
      pg8::EpiSwiGLU E{ACT, DFF};
      pg8::gemm_phase<pg8::EpiSwiGLU, pg8::StaticOrder, true, true>(lds, g, S, E); }
    GRID_BAR();
    { pg8::Gemm g{ACT, (const bf16*)(ws + WS_W1OUT), M, D, DFF}; pg8::StaticOrder S; S.init(M, D, G, bid);
      pg8::EpiPlain E{Yb, D, 1.0f};
      pg8::gemm_phase<pg8::EpiPlain, pg8::StaticOrder, true, true>(lds, g, S, E); }
    GRID_BAR();
    norm_pass<true, true>(in[0], Yb, args.out, Hb, MODV(0, 2), in[5], 0.5f, in[8], MODV(1, 1), MODV(1, 0), rowbeg, wave, FRESH_LANE());
    GRID_BAR();
    { pg8::Gemm g{Hb, (const bf16*)(ws + WS_WMIXA), M, 2048, D}; pg8::StaticOrder S; S.init(M, 2048, G, bid);
      pg8::EpiMix E{Qb, Kb, Ub};
      pg8::gemm_phase<pg8::EpiMix, pg8::StaticOrder, true, true>(lds, g, S, E); }
    { pg8::Gemm g{(const bf16*)(ws + WS_WMIXV), Hb, AW, M, D}; pg8::StaticOrder S; S.init(AW, M, G, bid);
      pg8::EpiPlain E{VT, M, 1.0f};
      pg8::gemm_phase<pg8::EpiPlain, pg8::StaticOrder, true, true>(lds, g, S, E); }
    GRID_BAR();
    {
        LAS float* cw = (LAS float*)lds;
        for (int i = tid; i < CK * AW / 4; i += NTHREADS) *(LAS f32x4*)(cw + 4 * i) = *(const f32x4*)(in[12] + 4 * i);
        __syncthreads();
        const int gw = bid * NWAVES + wave, NGW = G * NWAVES; const int lane6 = FRESH_LANE();
#ifndef NO_CONV
        for (int grp = gw; grp < M / 4; grp += NGW) conv_group(grp, Ub, CAT, cw, in[13], in[14], in[15], lane6);
#endif
        for (int v = bid; v < BATCH * NHEAD * 8; v += G) { const int bh = v >> 3, qb0 = 32 * (v & 7);
#ifndef NO_ATTN
            for (int j = 0; j < 4; ++j) attn_unit(Qb, Kb, VT, CAT, in[11], bh / NHEAD, bh % NHEAD, qb0 + 8 * j + wave, lane6);
#endif
        }
    }
    GRID_BAR();
    { pg8::Gemm g{CAT, (const bf16*)(ws + WS_WMO), M, D, D}; pg8::StaticOrder S; S.init(M, D, G, bid);
      pg8::EpiPlain E{Yb, D, 1.0f};
      pg8::gemm_phase<pg8::EpiPlain, pg8::StaticOrder, true, true>(lds, g, S, E); }
    GRID_BAR();
    norm_pass<true, true>(args.out, Yb, args.out, Hb, MODV(1, 2), in[9], 1.0f, in[17], MODV(2, 1), MODV(2, 0), rowbeg, wave, FRESH_LANE());
    GRID_BAR();
    { pg8::Gemm g{Hb, (const bf16*)(ws + WS_W2IN), M, 2 * DFF, D}; pg8::StaticOrder S; S.init(M, 2 * DFF, G, bid);
      pg8::EpiSwiGLU E{ACT, DFF};
      pg8::gemm_phase<pg8::EpiSwiGLU, pg8::StaticOrder, true, true>(lds, g, S, E); }
    GRID_BAR();
    { pg8::Gemm g{ACT, (const bf16*)(ws + WS_W2OUT), M, D, DFF}; pg8::StaticOrder S; S.init(M, D, G, bid);
      pg8::EpiPlain E{Yb, D, 1.0f};
      pg8::gemm_phase<pg8::EpiPlain, pg8::StaticOrder, true, true>(lds, g, S, E); }
    GRID_BAR();
    norm_pass<true, false>(args.out, Yb, args.out, nullptr, MODV(2, 2), in[18], 0.5f, nullptr, nullptr, nullptr, rowbeg, wave, FRESH_LANE());
}

extern "C" void kernel_launch(void* const* d_in, const int* in_sizes, int n_in, void* d_out, int out_size, void* d_ws, size_t ws_size, hipStream_t stream) {
    static int grid = 0;
    if (grid == 0) {
        if (n_in != 21 || in_sizes[0] != M * D || out_size != M * D || ws_size < WS_END) { fprintf(stderr, "kernel_launch: unexpected problem geometry (n_in %d, ws %zu)\n", n_in, ws_size); grid = -1; return; }
        int dev = 0, cus = 0, per_cu = 0;
        hipGetDevice(&dev); hipDeviceGetAttribute(&cus, hipDeviceAttributeMultiprocessorCount, dev);
        if (hipFuncSetAttribute((const void*)fwd_megakernel, hipFuncAttributeMaxDynamicSharedMemorySize, LDS_BYTES) != hipSuccess) { fprintf(stderr, "kernel_launch: hipFuncSetAttribute failed\n"); grid = -1; return; }
        hipOccupancyMaxActiveBlocksPerMultiprocessor(&per_cu, (const void*)fwd_megakernel, NTHREADS, LDS_BYTES);
        (void)hipGetLastError();
        if (per_cu < 1 || cus != 256) fprintf(stderr, "kernel_launch: note: occupancy %d blocks/CU, %d CUs\n", per_cu, cus);
        grid = 256;
    }
    if (grid < 0) return;
    Args a{};
    for (int i = 0; i < 21; ++i) a.in[i] = (const float*)d_in[i];
    a.out = (float*)d_out; a.ws = (unsigned char*)d_ws;
    void* kargs[] = {&a};
    hipError_t e = hipLaunchCooperativeKernel((const void*)fwd_megakernel, dim3(grid), dim3(NTHREADS), kargs, LDS_BYTES, stream);
    if (e != hipSuccess) fprintf(stderr, "kernel_launch: cooperative launch failed: %s\n", hipGetErrorString(e));
}
```

```cpp
#include <hip/hip_runtime.h>
#include <hip/hip_cooperative_groups.h>
#include <cstdio>
#include <cstdint>
namespace cg = cooperative_groups;
namespace pg8 {
#define PG8_LAS __attribute__((address_space(3)))
typedef unsigned short bf16_t;
typedef short bf16x8 __attribute__((ext_vector_type(8)));
typedef float f32x4 __attribute__((ext_vector_type(4)));
typedef unsigned u32x4 __attribute__((ext_vector_type(4)));
constexpr int BM = 256, BK = 64, HALF = 128, HTB = HALF * BK * 2  , STAGE_BYTES = 8 * HTB, NXCD = 8, WGM = 8;

__host__ __device__ __forceinline__ int lds_byte(int r, int c) { const int st = (r >> 4) * 2 + (c >> 5), rr = r & 15, cc = c & 31, ob = rr * 64 + cc * 2; return st * 1024 + (ob ^ (((ob >> 9) & 1) << 5)); }
__host__ __device__ __forceinline__ void stage_rc(int b, int& R, int& C) { const int st = b / 1024, sb = b % 1024, swz = sb ^ (((sb >> 9) & 1) << 5); R = (st >> 1) * 16 + swz / 64; C = (st & 1) * 32 + (swz % 64) / 2; }
__host__ __device__ __forceinline__ int perm32(int rho) { const int n = rho >> 4, i = rho & 15; return 8 * (i >> 2) + 4 * n + (i & 3); }

struct Unit { int pm, pn; };
struct Gemm { const bf16_t* A; const bf16_t* Bt; int M, N, K; };

struct StaticOrder {
    int nM, nN, nwg, G, c;
    __host__ __device__ void init(int M, int N, int G_, int c_) { nM = M / BM; nN = N / BM; nwg = nM * nN; G = G_; c = c_; }
    __host__ __device__ bool next(int i, Unit& u) const {
        const long L = (long)i * G + c; if (L >= nwg) return false;
        int wgid = (int)L; { const int q = nwg / NXCD, r = nwg % NXCD, xcd = wgid % NXCD, off = wgid / NXCD; wgid = (xcd < r ? xcd * (q + 1) : r * (q + 1) + (xcd - r) * q) + off; }
        const int nig = WGM * nN, gid = wgid / nig, fm = gid * WGM, gsz = (nM - fm) < WGM ? (nM - fm) : WGM;
        u.pm = fm + ((wgid % nig) % gsz); u.pn = (wgid % nig) / gsz; return true;
    }
    __device__ __forceinline__ void a_ready(const Unit&) const {}
    __device__ __forceinline__ void done(const Unit&) const {}
};

__device__ __forceinline__ unsigned cvt_pk_bf16(float lo, float hi) { unsigned r; asm volatile("v_cvt_pk_bf16_f32 %0, %1, %2" : "=v"(r) : "v"(lo), "v"(hi)); return r; }
typedef float f32x2 __attribute__((ext_vector_type(2)));
__device__ __forceinline__ float fast_sigmoid(float v) { return __builtin_amdgcn_rcpf(1.0f + __builtin_amdgcn_exp2f(-1.4426950408889634f * v)); }
struct EpiPlain {
    static constexpr bool PERM = true, AFTER_DRAIN = false;
    bf16_t* O; int ldc; float scale;
    __device__ __forceinline__ void operator()(const f32x4 (&acc)[2][2][4][2], const Unit& u, int wr, int wc, int fr, int fq) const {
        const int row0 = u.pm * BM + wr * 64 + fr, col0 = u.pn * BM + wc * 32 + 8 * fq;
#pragma unroll
        for (int ai = 0; ai < 2; ++ai)
#pragma unroll
            for (int m = 0; m < 4; ++m) { bf16_t* rowp = O + (size_t)(row0 + ai * HALF + m * 16) * ldc + col0;
#pragma unroll
                for (int bj = 0; bj < 2; ++bj) { const f32x4 v0 = acc[ai][bj][m][0] * scale, v1 = acc[ai][bj][m][1] * scale;
                    u32x4 w; w.x = cvt_pk_bf16(v0[0], v0[1]); w.y = cvt_pk_bf16(v0[2], v0[3]); w.z = cvt_pk_bf16(v1[0], v1[1]); w.w = cvt_pk_bf16(v1[2], v1[3]);
                    *(u32x4*)(rowp + bj * HALF) = w; } }
    }
};
struct EpiSwiGLU {
    static constexpr bool PERM = true, AFTER_DRAIN = false;
    bf16_t* O; int ldc;
    __device__ __forceinline__ void operator()(const f32x4 (&acc)[2][2][4][2], const Unit& u, int wr, int wc, int fr, int fq) const {
        const int row0 = u.pm * BM + wr * 64 + fr, col0 = u.pn * HALF + wc * 32 + 8 * fq;
#pragma unroll
        for (int ai = 0; ai < 2; ++ai)
#pragma unroll
            for (int m = 0; m < 4; ++m) { bf16_t* rowp = O + (size_t)(row0 + ai * HALF + m * 16) * ldc + col0;
                f32x4 r[2];
#pragma unroll
                for (int n = 0; n < 2; ++n) { const f32x4 g = acc[ai][0][m][n], up = acc[ai][1][m][n];
#pragma unroll
                    for (int e = 0; e < 4; ++e) r[n][e] = g[e] * fast_sigmoid(g[e]) * up[e]; }
                u32x4 w; w.x = cvt_pk_bf16(r[0][0], r[0][1]); w.y = cvt_pk_bf16(r[0][2], r[0][3]); w.z = cvt_pk_bf16(r[1][0], r[1][1]); w.w = cvt_pk_bf16(r[1][2], r[1][3]);
                *(u32x4*)rowp = w; }
    }
};
struct EpiMix {
    static constexpr bool PERM = true, AFTER_DRAIN = false;
    bf16_t *Q, *Kb, *U;
    __device__ __forceinline__ void operator()(const f32x4 (&acc)[2][2][4][2], const Unit& u, int wr, int wc, int fr, int fq) const {
        const int row0 = u.pm * BM + wr * 64 + fr;
        if (u.pn < 4) {
            bf16_t* base = (u.pn < 2) ? Q : Kb; const float sc = (u.pn < 2) ? 0.125f : 1.0f; const int col0 = (u.pn & 1) * BM + wc * 32 + 8 * fq;
#pragma unroll
            for (int ai = 0; ai < 2; ++ai)
#pragma unroll
                for (int m = 0; m < 4; ++m) { bf16_t* rowp = base + (size_t)(row0 + ai * HALF + m * 16) * 512 + col0;
#pragma unroll
                    for (int bj = 0; bj < 2; ++bj) { const f32x4 v0 = acc[ai][bj][m][0] * sc, v1 = acc[ai][bj][m][1] * sc;
                        u32x4 w; w.x = cvt_pk_bf16(v0[0], v0[1]); w.y = cvt_pk_bf16(v0[2], v0[3]); w.z = cvt_pk_bf16(v1[0], v1[1]); w.w = cvt_pk_bf16(v1[2], v1[3]);
                        *(u32x4*)(rowp + bj * HALF) = w; } }
        } else {
            const int col0 = (u.pn - 4) * HALF + wc * 32 + 8 * fq;
#pragma unroll
            for (int ai = 0; ai < 2; ++ai)
#pragma unroll
                for (int m = 0; m < 4; ++m) { bf16_t* rowp = U + (size_t)(row0 + ai * HALF + m * 16) * 512 + col0;
                    f32x4 r[2];
#pragma unroll
                    for (int n = 0; n < 2; ++n) { const f32x4 cv = acc[ai][0][m][n], cgt = acc[ai][1][m][n];
#pragma unroll
                        for (int e = 0; e < 4; ++e) r[n][e] = cv[e] * fast_sigmoid(cgt[e]); }
                    u32x4 w; w.x = cvt_pk_bf16(r[0][0], r[0][1]); w.y = cvt_pk_bf16(r[0][2], r[0][3]); w.z = cvt_pk_bf16(r[1][0], r[1][1]); w.w = cvt_pk_bf16(r[1][2], r[1][3]);
                    *(u32x4*)rowp = w; }
        }
    }
};
template <class Epi, class Sched, bool ALIGN_EPI = false, bool SP2 = false>
__device__ __forceinline__ void gemm_phase(PG8_LAS unsigned char* lds, const Gemm g, const Sched& S, const Epi& E) {
    int tid_ = threadIdx.x; asm volatile("" : "+v"(tid_));
    const int tid = tid_, wid = __builtin_amdgcn_readfirstlane(tid >> 6), lane = tid & 63, wr = wid >> 2, wc = wid & 3, fr = lane & 15, fq = lane >> 4;
    const int K = g.K, nt = K / BK;
    unsigned voffA[2], voffB[2];
#pragma unroll
    for (int i = 0; i < 2; ++i) { int R, C; stage_rc(tid * 16 + i * 8192, R, C); const int Rb = Epi::PERM ? ((R & ~31) + perm32(R & 31)) : R;
        voffA[i] = (unsigned)(R * K + C) * 2u; voffB[i] = (unsigned)(Rb * K + C) * 2u; }
    const size_t kstep = (size_t)(BK * 2);
    const size_t hstep = (size_t)HALF * K * 2;
    const size_t tstep = 2 * hstep;
    const unsigned ldsw = (unsigned)wid * 1024u;
    const int aoff = lds_byte(wr * 64 + fr, fq * 8), boff = lds_byte(wc * 32 + fr, fq * 8);
#define PG8_SA(b, h) (((b) * 2 + (h)) * HTB)
#define PG8_SB(b, h) ((4 + (b) * 2 + (h)) * HTB)
#define PG8_STAGE(bufoff, gbase, voff) do { _Pragma("unroll") for (int _i = 0; _i < 2; ++_i) \
        __builtin_amdgcn_global_load_lds((const unsigned*)((const char*)(gbase) + (voff)[_i]), (PG8_LAS unsigned*)(lds + (bufoff) + ldsw + _i * 8192), 16, 0, 0); } while (0)
#define PG8_LDA(dst, b, h) do { _Pragma("unroll") for (int m = 0; m < 4; ++m) _Pragma("unroll") for (int k = 0; k < 2; ++k) dst[m][k] = *(const PG8_LAS bf16x8*)(lds + PG8_SA(b, h) + aoff + m * 2048 + k * 1024); } while (0)
#define PG8_LDB(dst, b, h) do { _Pragma("unroll") for (int n = 0; n < 2; ++n) _Pragma("unroll") for (int k = 0; k < 2; ++k) dst[n][k] = *(const PG8_LAS bf16x8*)(lds + PG8_SB(b, h) + boff + n * 2048 + k * 1024); } while (0)
#define PG8_MMA(ai, bj, At, Bt) do { __builtin_amdgcn_s_setprio(1); _Pragma("unroll") for (int m = 0; m < 4; ++m) _Pragma("unroll") for (int n = 0; n < 2; ++n) _Pragma("unroll") for (int k = 0; k < 2; ++k) \
        acc[ai][bj][m][n] = __builtin_amdgcn_mfma_f32_16x16x32_bf16(Bt[n][k], At[m][k], acc[ai][bj][m][n], 0, 0, 0); __builtin_amdgcn_s_setprio(0); } while (0)
#define PG8_WAIT_V(n) asm volatile("s_waitcnt vmcnt(" #n ")" ::: "memory")
#define PG8_WAIT_L(n) asm volatile("s_waitcnt lgkmcnt(" #n ")" ::: "memory")
#define PG8_BAR __builtin_amdgcn_s_barrier()
#define PG8_SCHED __builtin_amdgcn_sched_barrier(0)
    Unit cur, nxt; int ui = 0;
    if (!S.next(0, cur)) return;
    f32x4 acc[2][2][4][2];
#pragma unroll
    for (int a = 0; a < 2; ++a)
#pragma unroll
        for (int b = 0; b < 2; ++b)
#pragma unroll
            for (int m = 0; m < 4; ++m)
#pragma unroll
                for (int n = 0; n < 2; ++n) acc[a][b][m][n] = (f32x4){0.f, 0.f, 0.f, 0.f};
    bf16x8 At[4][2], B0[2][2], B1[2][2];
    const char* cA = (const char*)g.A + (size_t)cur.pm * tstep; const char* cB = (const char*)g.Bt + (size_t)cur.pn * tstep;
    S.a_ready(cur);
    if constexpr (SP2) {
        PG8_STAGE(PG8_SB(0, 0), cB, voffB); PG8_STAGE(PG8_SB(0, 1), cB + hstep, voffB); PG8_STAGE(PG8_SA(0, 0), cA, voffA); PG8_STAGE(PG8_SA(0, 1), cA + hstep, voffA);
        if (wr == 1) PG8_BAR;
        PG8_WAIT_V(2); PG8_BAR;
        PG8_STAGE(PG8_SB(1, 0), cB + kstep, voffB); PG8_STAGE(PG8_SA(1, 0), cA + kstep, voffA); PG8_STAGE(PG8_SB(1, 1), cB + hstep + kstep, voffB);
        PG8_WAIT_V(6); PG8_BAR;
    } else {
        PG8_STAGE(PG8_SB(0, 0), cB, voffB); PG8_STAGE(PG8_SA(0, 0), cA, voffA); PG8_STAGE(PG8_SB(0, 1), cB + hstep, voffB); PG8_STAGE(PG8_SA(0, 1), cA + hstep, voffA);
        if (wr == 1) PG8_BAR;
        PG8_WAIT_V(4); PG8_BAR;
        PG8_STAGE(PG8_SB(1, 0), cB + kstep, voffB); PG8_STAGE(PG8_SA(1, 0), cA + kstep, voffA); PG8_STAGE(PG8_SB(1, 1), cB + hstep + kstep, voffB);
        PG8_WAIT_V(6); PG8_BAR;
    }
    for (;;) {
        const bool has_next = S.next(ui + 1, nxt);
        const char* nA = has_next ? (const char*)g.A + (size_t)nxt.pm * tstep : cA; const char* nB = has_next ? (const char*)g.Bt + (size_t)nxt.pn * tstep : cB;
        for (int t = 0; t < nt; t += 2) {
            const bool last = (t == nt - 2);
            const char* a1 = cA + (size_t)(t + 1) * kstep;
            const char* a2 = last ? nA : cA + (size_t)(t + 2) * kstep; const char* b2 = last ? nB : cB + (size_t)(t + 2) * kstep;
            const char* a3 = a2 + kstep; const char* b3 = b2 + kstep;
            if (last && has_next) S.a_ready(nxt);
            if constexpr (SP2) {
            PG8_LDB(B0, 0, 0); PG8_LDB(B1, 0, 1); PG8_SCHED; PG8_LDA(At, 0, 0); PG8_STAGE(PG8_SA(1, 1), a1 + hstep, voffA);
            PG8_WAIT_V(8); PG8_WAIT_L(0); PG8_BAR; PG8_MMA(0, 0, At, B0); PG8_MMA(0, 1, At, B1); PG8_BAR; PG8_SCHED;
            PG8_LDA(At, 0, 1); PG8_STAGE(PG8_SB(0, 0), b2, voffB); PG8_STAGE(PG8_SB(0, 1), b2 + hstep, voffB); PG8_STAGE(PG8_SA(0, 0), a2, voffA);
            PG8_WAIT_V(8); PG8_WAIT_L(0); PG8_BAR; PG8_MMA(1, 0, At, B0); PG8_MMA(1, 1, At, B1); PG8_BAR; PG8_SCHED;
            PG8_LDB(B0, 1, 0); PG8_LDB(B1, 1, 1); PG8_SCHED; PG8_LDA(At, 1, 0); PG8_STAGE(PG8_SA(0, 1), a2 + hstep, voffA);
            PG8_WAIT_V(8); PG8_WAIT_L(0); PG8_BAR; PG8_MMA(0, 0, At, B0); PG8_MMA(0, 1, At, B1); PG8_BAR; PG8_SCHED;
            PG8_LDA(At, 1, 1); PG8_STAGE(PG8_SB(1, 0), b3, voffB); PG8_STAGE(PG8_SB(1, 1), b3 + hstep, voffB); PG8_STAGE(PG8_SA(1, 0), a3, voffA);
            PG8_WAIT_V(8); PG8_WAIT_L(0); PG8_BAR; PG8_MMA(1, 0, At, B0); PG8_MMA(1, 1, At, B1); PG8_BAR; PG8_SCHED;
            } else {
            PG8_LDB(B0, 0, 0); PG8_SCHED; PG8_LDA(At, 0, 0); PG8_STAGE(PG8_SA(1, 1), a1 + hstep, voffA);
            PG8_WAIT_L(8); PG8_BAR; PG8_WAIT_L(0); PG8_MMA(0, 0, At, B0); PG8_BAR; PG8_SCHED;
            PG8_LDB(B1, 0, 1); PG8_STAGE(PG8_SB(0, 0), b2, voffB);
            PG8_BAR; PG8_WAIT_L(0); PG8_MMA(0, 1, At, B1); PG8_BAR;
            PG8_LDA(At, 0, 1); PG8_STAGE(PG8_SA(0, 0), a2, voffA);
            PG8_BAR; PG8_WAIT_L(0); PG8_MMA(1, 0, At, B0); PG8_BAR; PG8_SCHED;
            PG8_STAGE(PG8_SB(0, 1), b2 + hstep, voffB);
            PG8_WAIT_V(6); PG8_BAR; PG8_MMA(1, 1, At, B1); PG8_BAR;
            PG8_LDB(B0, 1, 0); PG8_SCHED; PG8_LDA(At, 1, 0); PG8_STAGE(PG8_SA(0, 1), a2 + hstep, voffA);
            PG8_WAIT_L(8); PG8_BAR; PG8_WAIT_L(0); PG8_MMA(0, 0, At, B0); PG8_BAR; PG8_SCHED;
            PG8_LDB(B1, 1, 1); PG8_STAGE(PG8_SB(1, 0), b3, voffB);
            PG8_BAR; PG8_WAIT_L(0); PG8_MMA(0, 1, At, B1); PG8_BAR;
            PG8_LDA(At, 1, 1); PG8_STAGE(PG8_SA(1, 0), a3, voffA);
            PG8_BAR; PG8_WAIT_L(0); PG8_MMA(1, 0, At, B0); PG8_BAR; PG8_SCHED;
            PG8_STAGE(PG8_SB(1, 1), b3 + hstep, voffB);
            PG8_WAIT_V(6); PG8_BAR; PG8_MMA(1, 1, At, B1); PG8_BAR;
            }
        }
        if constexpr (ALIGN_EPI) { if (wr == 0) PG8_BAR; }
        if constexpr (!Epi::AFTER_DRAIN) { E(acc, cur, wr, wc, fr, fq); S.done(cur); }
        if (!has_next) break;
#pragma unroll
        for (int a = 0; a < 2; ++a)
#pragma unroll
            for (int b = 0; b < 2; ++b)
#pragma unroll
                for (int m = 0; m < 4; ++m)
#pragma unroll
                    for (int n = 0; n < 2; ++n) acc[a][b][m][n] = (f32x4){0.f, 0.f, 0.f, 0.f};
        cur = nxt; cA = nA; cB = nB; ++ui;
        if constexpr (ALIGN_EPI) { if (wr == 1) PG8_BAR; }
    }
    PG8_WAIT_V(0);
    if constexpr (!ALIGN_EPI) { if (wr == 0) PG8_BAR; }
    PG8_BAR;
    if constexpr (Epi::AFTER_DRAIN) { E.fused(acc, cur, wr, wc, fr, fq, lds, wid, lane); S.done(cur); }
#undef PG8_SA
#undef PG8_SB
#undef PG8_STAGE
#undef PG8_LDA
#undef PG8_LDB
#undef PG8_MMA
#undef PG8_WAIT_V
#undef PG8_WAIT_L
#undef PG8_BAR
#undef PG8_SCHED
}
}

constexpr int BATCH = 4, SEQ = 8192, D = 1024, M = BATCH * SEQ, DFF = 2816, AW = 512, NHEAD = 8, HD = 64, CK = 31, NMOD = 9 * D;
constexpr float RMS_EPS = 1e-6f, LN_EPS = 1e-5f;
constexpr int NWAVES = 8, NTHREADS = 512;
constexpr int LDS_BYTES = 147456;
constexpr int KCH = 16;
constexpr float STICK_EXIT = -110.0f;

constexpr size_t MiB = 1u << 20;
constexpr size_t WS_CTL = 0, WS_PART = 1 * MiB, WS_MODTAB = 4 * MiB;
constexpr size_t WS_W1IN = 8 * MiB, WS_W1OUT = 19 * MiB, WS_WMIXA = 25 * MiB, WS_WMIXV = 29 * MiB, WS_WMO = 30 * MiB, WS_W2IN = 32 * MiB, WS_W2OUT = 43 * MiB;
constexpr size_t WS_H = 64 * MiB, WS_Y = 128 * MiB, WS_ACT = 192 * MiB, WS_Q = 192 * MiB, WS_K = 224 * MiB, WS_VT = 256 * MiB, WS_U = 288 * MiB, WS_CAT = 368 * MiB, WS_END = 432 * MiB;

#define LAS __attribute__((address_space(3)))
typedef unsigned short bf16;
typedef float f32x4 __attribute__((ext_vector_type(4)));
typedef float f32x16 __attribute__((ext_vector_type(16)));
typedef short bf16x8 __attribute__((ext_vector_type(8)));
typedef short s16x4 __attribute__((ext_vector_type(4)));
typedef unsigned u32x2 __attribute__((ext_vector_type(2)));
typedef unsigned u32x4 __attribute__((ext_vector_type(4)));
typedef float f32x2_t __attribute__((ext_vector_type(2)));
typedef __bf16 bf16x2_t __attribute__((ext_vector_type(2)));
#define LDS_WAIT() asm volatile("s_waitcnt lgkmcnt(0)" ::: "memory")

__device__ __forceinline__ unsigned pk2(float lo, float hi) { f32x2_t v = {lo, hi}; bf16x2_t b = __builtin_convertvector(v, bf16x2_t); return __builtin_bit_cast(unsigned, b); }
__device__ __forceinline__ float bf_lo(unsigned u) { return __uint_as_float(u << 16); }
__device__ __forceinline__ float bf_hi(unsigned u) { return __uint_as_float(u & 0xffff0000u); }
__device__ __forceinline__ float wave_sum(float v) {
#pragma unroll
    for (int o = 1; o < 64; o <<= 1) v += __shfl_xor(v, o);
    return v;
}
__device__ __forceinline__ float rdlane(float v, int l) { return __uint_as_float((unsigned)__builtin_amdgcn_readlane((int)__float_as_uint(v), l)); }

__device__ __forceinline__ void tr_item(const float* __restrict__ W, int K, int N, bf16* dst, LAS float* scr, int k0, int n0, int lane) {
#pragma unroll 8
    for (int i = 0; i < 32; ++i) { const int kk = 2 * i + (lane >> 5); scr[kk * 33 + (lane & 31)] = W[(size_t)(k0 + kk) * N + n0 + (lane & 31)]; }
    LDS_WAIT(); asm volatile("" ::: "memory");
    const int c = lane & 7;
#pragma unroll
    for (int j = 0; j < 4; ++j) { const int n = (lane >> 3) + 8 * j; const LAS float* s = scr + (8 * c) * 33 + n;
        u32x4 o; o.x = pk2(s[0 * 33], s[1 * 33]); o.y = pk2(s[2 * 33], s[3 * 33]); o.z = pk2(s[4 * 33], s[5 * 33]); o.w = pk2(s[6 * 33], s[7 * 33]);
        *(u32x4*)(dst + (size_t)n * K + k0 + 8 * c) = o; }
    LDS_WAIT(); asm volatile("" ::: "memory");
}
__device__ __forceinline__ int ffin_row(int n0) { const int bj = n0 / DFF, c = n0 % DFF; return 256 * (c / 128) + 128 * bj + (c % 128); }
__device__ __forceinline__ void tr_matrix(int mat, int r, const float* const* in, unsigned char* ws, LAS float* scr, int lane) {
    if (mat == 0 || mat == 4) {
        const int nblk = 2 * DFF / 32, kb = r / nblk, nb = r % nblk, n0 = 32 * nb;
        bf16* dst = (bf16*)(ws + (mat == 0 ? WS_W1IN : WS_W2IN)) + (size_t)ffin_row(n0) * D;
        tr_item(in[mat == 0 ? 6 : 19], D, 2 * DFF, dst, scr, 64 * kb, n0, lane);
    } else if (mat == 1 || mat == 5) {
        const int nblk = D / 32, kb = r / nblk, nb = r % nblk, n0 = 32 * nb;
        bf16* dst = (bf16*)(ws + (mat == 1 ? WS_W1OUT : WS_W2OUT)) + (size_t)n0 * DFF;
        tr_item(in[mat == 1 ? 7 : 20], DFF, D, dst, scr, 64 * kb, n0, lane);
    } else if (mat == 2) {
        const int nblk = 2560 / 32, kb = r / nblk, nb = r % nblk, n0 = 32 * nb;
        bf16* dst;
        if (n0 < 1024) dst = (bf16*)(ws + WS_WMIXA) + (size_t)n0 * D;
        else if (n0 < 1536) dst = (bf16*)(ws + WS_WMIXV) + (size_t)(n0 - 1024) * D;
        else { const int c = n0 - 1536, bj = c / 512, cc = c % 512; dst = (bf16*)(ws + WS_WMIXA) + (size_t)(1024 + 256 * (cc / 128) + 128 * bj + (cc % 128)) * D; }
        tr_item(in[10], D, 2560, dst, scr, 64 * kb, n0, lane);
    } else {
        const int nblk = D / 32, kb = r / nblk, nb = r % nblk, n0 = 32 * nb;
        bf16* dst = (bf16*)(ws + WS_WMO) + (size_t)n0 * D;
        tr_item(in[16], D, D, dst, scr, 64 * kb, n0, lane);
    }
}
__device__ __forceinline__ void ada_item(int r, const float* __restrict__ cvec, const float* __restrict__ w_ada, float* part, int lane) {
    const int cgp = r / KCH, kc = r % KCH, n = 64 * cgp + lane;
    float sc[4], acc[4];
#pragma unroll
    for (int b = 0; b < 4; ++b) { const float v = cvec[b * D + 64 * kc + lane]; sc[b] = v / (1.0f + __expf(-v)); acc[b] = 0.f; }
    const float* wp = w_ada + (size_t)(64 * kc) * NMOD + n;
#pragma unroll
    for (int kk = 0; kk < 64; ++kk) { const float w = wp[(size_t)kk * NMOD];
#pragma unroll
        for (int b = 0; b < 4; ++b) acc[b] += rdlane(sc[b], kk) * w; }
#pragma unroll
    for (int b = 0; b < 4; ++b) part[(size_t)(kc * 4 + b) * NMOD + n] = acc[b];
}
__device__ __forceinline__ void p0_prologue(const float* const* in, unsigned char* ws, LAS unsigned char* lds, int wave, int lane) {
    LAS float* scr = (LAS float*)(lds + wave * 16384);
    const int gw = blockIdx.x * NWAVES + wave, NGW = gridDim.x * NWAVES;
    constexpr int I_IN = (D / 64) * (2 * DFF / 32), I_OUT = (DFF / 64) * (D / 32), I_MIX = (D / 64) * (2560 / 32), I_MO = (D / 64) * (D / 32);
    constexpr int NTR = 2 * I_IN + 2 * I_OUT + I_MIX + I_MO, NADA = (NMOD / 64) * KCH;
    for (int it = gw; it < NTR + NADA; it += NGW) {
        int r = it;
        if (r < I_IN) { tr_matrix(0, r, in, ws, scr, lane); continue; } r -= I_IN;
        if (r < I_OUT) { tr_matrix(1, r, in, ws, scr, lane); continue; } r -= I_OUT;
        if (r < I_MIX) { tr_matrix(2, r, in, ws, scr, lane); continue; } r -= I_MIX;
        if (r < I_MO) { tr_matrix(3, r, in, ws, scr, lane); continue; } r -= I_MO;
        if (r < I_IN) { tr_matrix(4, r, in, ws, scr, lane); continue; } r -= I_IN;
        if (r < I_OUT) { tr_matrix(5, r, in, ws, scr, lane); continue; } r -= I_OUT;
#ifndef NO_ADA
        ada_item(r, in[1], in[2], (float*)(ws + WS_PART), lane);
#endif
    }
}

template <bool HAS_Y, bool HAS_H>
__device__ __forceinline__ void norm_pass(const float* xin, const bf16* y, float* xout, bf16* h, const float* gate, const float* gpost, float rw,
                                          const float* gpre, const float* scale, const float* shift, int rowbeg, int wave, int lane) {
    f32x4 A[4], B[4], C[4];
#pragma unroll
    for (int j = 0; j < 4; ++j) { const int c = 4 * lane + 256 * j;
        if (HAS_Y) { const f32x4 g = *(const f32x4*)(gate + c), gp = *(const f32x4*)(gpost + c); A[j] = (g + 1.0f) * gp * rw; }
        if (HAS_H) { const f32x4 s = *(const f32x4*)(scale + c), gp = *(const f32x4*)(gpre + c); B[j] = (s + 1.0f) * gp; C[j] = *(const f32x4*)(shift + c); } }
    for (int i = 0; i < 16; ++i) {
        const size_t row = (size_t)(rowbeg + wave * 16 + i);
        f32x4 x[4]; u32x2 yv[4];
#pragma unroll
        for (int j = 0; j < 4; ++j) x[j] = *(const f32x4*)(xin + row * D + 4 * lane + 256 * j);
        if (HAS_Y) {
#pragma unroll
            for (int j = 0; j < 4; ++j) yv[j] = *(const u32x2*)(y + row * D + 4 * lane + 256 * j);
            f32x4 yf[4]; float ss = 0.f;
#pragma unroll
            for (int j = 0; j < 4; ++j) { yf[j] = (f32x4){bf_lo(yv[j].x), bf_hi(yv[j].x), bf_lo(yv[j].y), bf_hi(yv[j].y)}; ss += (yf[j].x * yf[j].x + yf[j].y * yf[j].y) + (yf[j].z * yf[j].z + yf[j].w * yf[j].w); }
            const float r = 1.0f / sqrtf(wave_sum(ss) * (1.0f / D) + RMS_EPS);
#pragma unroll
            for (int j = 0; j < 4; ++j) { x[j] = x[j] + A[j] * yf[j] * r; *(f32x4*)(xout + row * D + 4 * lane + 256 * j) = x[j]; }
        }
        if (HAS_H) {
            float ss = 0.f;
#pragma unroll
            for (int j = 0; j < 4; ++j) ss += (x[j].x * x[j].x + x[j].y * x[j].y) + (x[j].z * x[j].z + x[j].w * x[j].w);
            const float r = 1.0f / sqrtf(wave_sum(ss) * (1.0f / D) + RMS_EPS);
#pragma unroll
            for (int j = 0; j < 4; ++j) { const f32x4 o = x[j] * r * B[j] + C[j]; u32x2 w; w.x = pk2(o.x, o.y); w.y = pk2(o.z, o.w); *(u32x2*)(h + row * D + 4 * lane + 256 * j) = w; }
        }
    }
}

__device__ __forceinline__ void conv_group(int grp, const bf16* U, bf16* cat, const LAS float* cw, const float* conv_b, const float* ln_g, const float* ln_b, int lane) {
    const int tok0 = grp * 4, s0 = tok0 % SEQ;
    float acc[4][8], ww[4][8];
#pragma unroll
    for (int i = 0; i < 4; ++i)
#pragma unroll
        for (int e = 0; e < 8; ++e) { acc[i][e] = 0.f; ww[i][e] = 0.f; }
    const bf16* up = U + (size_t)tok0 * AW + 8 * lane;
#pragma unroll 4
    for (int j = 0; j < 36; ++j) {
#pragma unroll
        for (int e = 0; e < 8; ++e) { ww[3][e] = ww[2][e]; ww[2][e] = ww[1][e]; ww[1][e] = ww[0][e]; }
        if (j < CK) { const f32x4 w0 = *(const LAS f32x4*)(cw + j * AW + 8 * lane), w1 = *(const LAS f32x4*)(cw + j * AW + 8 * lane + 4);
#pragma unroll
            for (int e = 0; e < 4; ++e) { ww[0][e] = w0[e]; ww[0][4 + e] = w1[e]; }
        } else {
#pragma unroll
            for (int e = 0; e < 8; ++e) ww[0][e] = 0.f; }
        float xr[8];
        if (s0 - 30 + j >= 0 && j < 34) { const u32x4 v = *(const u32x4*)(up + (ptrdiff_t)(j - 30) * AW);
            xr[0] = bf_lo(v.x); xr[1] = bf_hi(v.x); xr[2] = bf_lo(v.y); xr[3] = bf_hi(v.y); xr[4] = bf_lo(v.z); xr[5] = bf_hi(v.z); xr[6] = bf_lo(v.w); xr[7] = bf_hi(v.w);
        } else {
#pragma unroll
            for (int e = 0; e < 8; ++e) xr[e] = 0.f; }
#pragma unroll
        for (int i = 0; i < 4; ++i)
#pragma unroll
            for (int e = 0; e < 8; ++e) acc[i][e] += ww[i][e] * xr[e];
    }
    const f32x4 b0 = *(const f32x4*)(conv_b + 8 * lane), b1 = *(const f32x4*)(conv_b + 8 * lane + 4);
    const f32x4 g0 = *(const f32x4*)(ln_g + 8 * lane), g1 = *(const f32x4*)(ln_g + 8 * lane + 4);
    const f32x4 lb0 = *(const f32x4*)(ln_b + 8 * lane), lb1 = *(const f32x4*)(ln_b + 8 * lane + 4);
#pragma unroll
    for (int i = 0; i < 4; ++i) {
        float v[8]; float s = 0.f;
#pragma unroll
        for (int e = 0; e < 8; ++e) { v[e] = acc[i][e] + (e < 4 ? b0[e] : b1[e - 4]); s += v[e]; }
        const float mean = wave_sum(s) * (1.0f / AW); float q = 0.f;
#pragma unroll
        for (int e = 0; e < 8; ++e) { v[e] -= mean; q += v[e] * v[e]; }
        const float rstd = 1.0f / sqrtf(wave_sum(q) * (1.0f / AW) + LN_EPS);
        float o[8];
#pragma unroll
        for (int e = 0; e < 8; ++e) { const float t = v[e] * rstd * (e < 4 ? g0[e] : g1[e - 4]) + (e < 4 ? lb0[e] : lb1[e - 4]); o[e] = t * pg8::fast_sigmoid(t); }
        u32x4 w; w.x = pk2(o[0], o[1]); w.y = pk2(o[2], o[3]); w.z = pk2(o[4], o[5]); w.w = pk2(o[6], o[7]);
        *(u32x4*)(cat + (size_t)(tok0 + i) * D + AW + 8 * lane) = w;
    }
}

__device__ __forceinline__ int crow(int r, int hi) { return (r & 3) + 8 * (r >> 2) + 4 * hi; }
__device__ __forceinline__ void attn_unit(const bf16* __restrict__ Q, const bf16* __restrict__ K, const bf16* __restrict__ VT, bf16* cat, const float* __restrict__ g_attn, int b, int h, int qb, int lane) {
    const int r32 = lane & 31, hi = lane >> 5;
    const size_t rowbase = (size_t)b * SEQ;
    const int t0 = qb * 32;
    bf16x8 qf[4];
    { const bf16* qp = Q + (rowbase + t0 + r32) * AW + h * HD + 8 * hi;
#pragma unroll
      for (int d0 = 0; d0 < 4; ++d0) qf[d0] = *(const bf16x8*)(qp + 16 * d0); }
    f32x16 o0, o1;
#pragma unroll
    for (int r = 0; r < 16; ++r) { o0[r] = 0.f; o1[r] = 0.f; }
    float carry = 0.f;
    for (int kb = qb; kb >= 0; --kb) {
        const int s0 = kb * 32;
        const bf16* kp = K + (rowbase + s0 + r32) * AW + h * HD + 8 * hi;
        bf16x8 kf[4];
#pragma unroll
        for (int d0 = 0; d0 < 4; ++d0) kf[d0] = *(const bf16x8*)(kp + 16 * d0);
        const bf16* vp = VT + (size_t)(h * HD + r32) * M + rowbase + s0 + 4 * hi;
        s16x4 va[2][2][2];
#pragma unroll
        for (int db = 0; db < 2; ++db)
#pragma unroll
            for (int ks = 0; ks < 2; ++ks) { va[db][ks][0] = *(const s16x4*)(vp + (size_t)db * 32 * M + 16 * ks); va[db][ks][1] = *(const s16x4*)(vp + (size_t)db * 32 * M + 16 * ks + 8); }
        f32x16 p;
#pragma unroll
        for (int r = 0; r < 16; ++r) p[r] = 0.f;
#pragma unroll
        for (int d0 = 0; d0 < 4; ++d0) p = __builtin_amdgcn_mfma_f32_32x32x16_bf16(kf[d0], qf[d0], p, 0, 0, 0);
        const bool diag = (kb == qb);
        float L[16];
#pragma unroll
        for (int r = 0; r < 16; ++r) { const float z = p[r];
            const float sp = fmaxf(z, 0.f) + 0.6931471805599453f * __builtin_amdgcn_logf(1.0f + __builtin_amdgcn_exp2f(-1.4426950408889634f * fabsf(z)));
            const bool valid = !diag || (crow(r, hi) < r32);
            L[r] = valid ? -sp : 0.f; }
        float E[4], O[4];
#pragma unroll
        for (int c = 0; c < 4; ++c) { const float gs = (L[4 * c] + L[4 * c + 1]) + (L[4 * c + 2] + L[4 * c + 3]);
            auto rr = __builtin_amdgcn_permlane32_swap(__float_as_uint(gs), __float_as_uint(gs), false, false);
            E[c] = __uint_as_float(rr[0]); O[c] = __uint_as_float(rr[1]); }
        float T[4]; T[3] = 0.f; T[2] = E[3] + O[3]; T[1] = T[2] + (E[2] + O[2]); T[0] = T[1] + (E[1] + O[1]);
        const float total = T[0] + (E[0] + O[0]);
        float w[16];
#pragma unroll
        for (int c = 0; c < 4; ++c) {
            const float after = carry + T[c] + (hi == 0 ? O[c] : 0.f);
            const float s3 = L[4 * c + 3] + after, s2 = L[4 * c + 2] + s3, s1 = L[4 * c + 1] + s2, s0_ = L[4 * c] + s1;
            const float ss[4] = {s0_, s1, s2, s3};
#pragma unroll
            for (int i = 0; i < 4; ++i) { const int r = 4 * c + i; const bool valid = !diag || (crow(r, hi) < r32);
                const float e = __builtin_amdgcn_exp2f(1.4426950408889634f * (p[r] + ss[i]));
                w[r] = valid ? e : 0.f; }
        }
        carry += total;
#pragma unroll
        for (int ks = 0; ks < 2; ++ks) {
            u32x4 pw; pw.x = pk2(w[8 * ks], w[8 * ks + 1]); pw.y = pk2(w[8 * ks + 2], w[8 * ks + 3]); pw.z = pk2(w[8 * ks + 4], w[8 * ks + 5]); pw.w = pk2(w[8 * ks + 6], w[8 * ks + 7]);
            const bf16x8 pb = __builtin_bit_cast(bf16x8, pw);
            const bf16x8 a0 = __builtin_shufflevector(va[0][ks][0], va[0][ks][1], 0, 1, 2, 3, 4, 5, 6, 7);
            const bf16x8 a1 = __builtin_shufflevector(va[1][ks][0], va[1][ks][1], 0, 1, 2, 3, 4, 5, 6, 7);
            o0 = __builtin_amdgcn_mfma_f32_32x32x16_bf16(a0, pb, o0, 0, 0, 0);
            o1 = __builtin_amdgcn_mfma_f32_32x32x16_bf16(a1, pb, o1, 0, 0, 0);
        }
        if (__all(carry < STICK_EXIT)) break;
    }
    float ss = 0.f;
#pragma unroll
    for (int r = 0; r < 16; ++r) ss += o0[r] * o0[r] + o1[r] * o1[r];
    { auto rr = __builtin_amdgcn_permlane32_swap(__float_as_uint(ss), __float_as_uint(ss), false, false); ss = __uint_as_float(rr[0]) + __uint_as_float(rr[1]); }
    const float rstd = 1.0f / sqrtf(ss * (1.0f / HD) + RMS_EPS);
    bf16* op = cat + (rowbase + t0 + r32) * D + h * HD + 4 * hi;
    const float* gp = g_attn + h * HD + 4 * hi;
#pragma unroll
    for (int c = 0; c < 4; ++c) {
        const f32x4 ga = *(const f32x4*)(gp + 8 * c), gb = *(const f32x4*)(gp + 32 + 8 * c);
        u32x2 wa, wb;
        wa.x = pk2(o0[4 * c] * rstd * ga.x, o0[4 * c + 1] * rstd * ga.y); wa.y = pk2(o0[4 * c + 2] * rstd * ga.z, o0[4 * c + 3] * rstd * ga.w);
        wb.x = pk2(o1[4 * c] * rstd * gb.x, o1[4 * c + 1] * rstd * gb.y); wb.y = pk2(o1[4 * c + 2] * rstd * gb.z, o1[4 * c + 3] * rstd * gb.w);
        *(u32x2*)(op + 8 * c) = wa; *(u32x2*)(op + 32 + 8 * c) = wb;
    }
}

#define XB_TMO      128
#define XB_XCNT(j)  (256  + 64 * (j))
#define XB_XSUB(j)  (1280 + 64 * (j))
#define XB_XGEN(j)  (2304 + 64 * (j))
#define XB_TOP      3328
#define XB_TOPGEN   3392
#define XCD_BAR_WORDS 3456
#define XB_SPIN_CAP (1u << 18)

__device__ __forceinline__ unsigned xb_ld(unsigned* p)              { return __hip_atomic_load(p, __ATOMIC_RELAXED, __HIP_MEMORY_SCOPE_AGENT); }
__device__ __forceinline__ unsigned xb_add(unsigned* p, unsigned v) { return __hip_atomic_fetch_add(p, v, __ATOMIC_RELAXED, __HIP_MEMORY_SCOPE_AGENT); }
__device__ __forceinline__ unsigned xb_xcc_id() { return (unsigned)__builtin_amdgcn_s_getreg((3 << 11) | 20) & 0xFu; }
#define XB_SPIN(cond, bar) do { unsigned _sp = 0; while (cond) { __builtin_amdgcn_s_sleep(1); \
    if ((++_sp & 255u) == 0u) { if (xb_ld(&(bar)[XB_TMO])) break; if (_sp > XB_SPIN_CAP) { atomicAdd(&(bar)[XB_TMO], 1u); break; } } } } while (0)

struct XcdBarrier {
    unsigned* bar; unsigned x;
    volatile LAS unsigned* st;
};

__device__ __forceinline__ XcdBarrier xcd_barrier_post(unsigned* bar, volatile LAS unsigned* st) {
    XcdBarrier b; b.bar = bar; b.x = xb_xcc_id(); b.st = st;
    if (threadIdx.x == 0) (void)xb_add(&bar[XB_XCNT(b.x)], 1u);
    return b;
}
__device__ __forceinline__ void xcd_barrier_complete(unsigned* bar, unsigned x, unsigned& nloc, unsigned& nx) {
    const unsigned G = gridDim.x * gridDim.y * gridDim.z;
    unsigned sum, cnt, mine, sp = 0u;
    for (;;) {
        sum = 0u; cnt = 0u; mine = 0u;
#pragma unroll
        for (unsigned j = 0; j < 16; ++j) { const unsigned c = xb_ld(&bar[XB_XCNT(j)]); sum += c; cnt += (c > 0u) ? 1u : 0u; mine = (j == x) ? c : mine; }
        if (sum == G) break;
        __builtin_amdgcn_s_sleep(1);
        if ((++sp & 255u) == 0u) { if (xb_ld(&bar[XB_TMO])) break; if (sp > XB_SPIN_CAP) { atomicAdd(&bar[XB_TMO], 1u); break; } }
    }
    nloc = mine > 0u ? mine : 1u; nx = cnt > 0u ? cnt : 1u;
}

__device__ __forceinline__ void xcd_barrier(const XcdBarrier& b) {
    asm volatile("s_waitcnt vmcnt(0)" ::: "memory");
    __syncthreads();
    if (threadIdx.x == 0) {
        unsigned* bar = b.bar;
        __builtin_amdgcn_s_waitcnt(0);
        unsigned nloc = b.st[0], nx = b.st[1];
        if (nloc == 0u) { xcd_barrier_complete(bar, b.x, nloc, nx); b.st[0] = nloc; b.st[1] = nx; }
        const unsigned old = xb_add(&bar[XB_XSUB(b.x)], 1u);
        const unsigned gen = old / nloc;
        if (old + 1u == (gen + 1u) * nloc) {
            __builtin_amdgcn_fence(__ATOMIC_RELEASE, "agent");
            asm volatile("s_waitcnt vmcnt(0)" ::: "memory");
            const unsigned og = xb_add(&bar[XB_TOP], 1u);
            const unsigned tg = og / nx;
            if (og + 1u == (tg + 1u) * nx) xb_add(&bar[XB_TOPGEN], 1u);
            else XB_SPIN(xb_ld(&bar[XB_TOPGEN]) == tg, bar);
            __builtin_amdgcn_fence(__ATOMIC_ACQUIRE, "agent");
            xb_add(&bar[XB_XGEN(b.x)], 1u);
            asm volatile("s_waitcnt vmcnt(0)" ::: "memory");
        } else {
            XB_SPIN(xb_ld(&bar[XB_XGEN(b.x)]) == gen, bar);
            __builtin_amdgcn_fence(__ATOMIC_ACQUIRE, "agent");
            asm volatile("s_waitcnt vmcnt(0)" ::: "memory");
        }
    }
    __syncthreads();
}

struct Args { const float* in[21]; float* out; unsigned char* ws; };
__global__ void __launch_bounds__(NTHREADS, 2) fwd_megakernel(Args args) {
    extern __shared__ __attribute__((aligned(16))) unsigned char lds_raw[];
    LAS unsigned char* lds = (LAS unsigned char*)lds_raw;
    cg::grid_group grid = cg::this_grid();
    const int tid = threadIdx.x, lane = tid & 63, wave = __builtin_amdgcn_readfirstlane(tid >> 6);
    const int G = gridDim.x, bid = blockIdx.x;
    unsigned char* ws = args.ws;
    const float* const* in = args.in;
    bf16* Hb = (bf16*)(ws + WS_H); bf16* Yb = (bf16*)(ws + WS_Y); bf16* ACT = (bf16*)(ws + WS_ACT);
    bf16* Qb = (bf16*)(ws + WS_Q); bf16* Kb = (bf16*)(ws + WS_K); bf16* VT = (bf16*)(ws + WS_VT); bf16* Ub = (bf16*)(ws + WS_U); bf16* CAT = (bf16*)(ws + WS_CAT);
    float* part = (float*)(ws + WS_PART); float* modtab = (float*)(ws + WS_MODTAB);
    for (int u = tid; u < (LDS_BYTES - 131072) / 4; u += NTHREADS) ((LAS unsigned*)(lds + 131072))[u] = 0u;
    __syncthreads();
    XcdBarrier bar = xcd_barrier_post((unsigned*)(ws + WS_CTL), (volatile LAS unsigned*)(lds + 131072 + 64));
    const int rowbeg = bid * (M / 256), batch = rowbeg / SEQ;
#define GRID_BAR() xcd_barrier(bar)
#define FRESH_LANE() ({ int l_ = lane; asm volatile("" : "+v"(l_)); l_; })
#define MODV(sub, j) (modtab + ((size_t)batch * 9 + (sub) * 3 + (j)) * D)

    p0_prologue(in, ws, lds, wave, FRESH_LANE());
    grid.sync();

    {
        if (tid < 36) { const int f4 = bid * 36 + tid;
            const int bb = f4 / (NMOD / 4), off = (f4 % (NMOD / 4)) * 4;
            f32x4 s = *(const f32x4*)(in[3] + off);
#pragma unroll
            for (int kc = 0; kc < KCH; ++kc) s = s + *(const f32x4*)(part + (size_t)(kc * 4 + bb) * NMOD + off);
            *(f32x4*)(modtab + (size_t)bb * NMOD + off) = s; }
        LAS float* ml = (LAS float*)lds;
        { const int off = tid * 4; f32x4 s = *(const f32x4*)(in[3] + off);
#pragma unroll
          for (int kc = 0; kc < KCH; ++kc) s = s + *(const f32x4*)(part + (size_t)(kc * 4 + batch) * NMOD + off);
          *(LAS f32x4*)(ml + off) = s; }
        __syncthreads();
        norm_pass<false, true>(in[0], nullptr, nullptr, Hb, nullptr, nullptr, 0.f, in[4], (const float*)(ml + D), (const float*)ml, rowbeg, wave, FRESH_LANE());
    }
    GRID_BAR();

    { pg8::Gemm g{Hb, (const bf16*)(ws + WS_W1IN), M, 2 * DFF, D}; pg8::StaticOrder S; S.init(M, 2 * DFF, G, bid);
      pg8::EpiSwiGLU E{ACT, DFF};
      pg8::gemm_phase<pg8::EpiSwiGLU, pg8::StaticOrder, true, true>(lds, g, S, E); }
    GRID_BAR();
    { pg8::Gemm g{ACT, (const bf16*)(ws + WS_W1OUT), M, D, DFF}; pg8::StaticOrder S; S.init(M, D, G, bid);
      pg8::EpiPlain E{Yb, D, 1.0f};
      pg8::gemm_phase<pg8::EpiPlain, pg8::StaticOrder, true, true>(lds, g, S, E); }
    GRID_BAR();
    norm_pass<true, true>(in[0], Yb, args.out, Hb, MODV(0, 2), in[5], 0.5f, in[8], MODV(1, 1), MODV(1, 0), rowbeg, wave, FRESH_LANE());
    GRID_BAR();
    { pg8::Gemm g{Hb, (const bf16*)(ws + WS_WMIXA), M, 2048, D}; pg8::StaticOrder S; S.init(M, 2048, G, bid);
      pg8::EpiMix E{Qb, Kb, Ub};
      pg8::gemm_phase<pg8::EpiMix, pg8::StaticOrder, true, true>(lds, g, S, E); }
    { pg8::Gemm g{(const bf16*)(ws + WS_WMIXV), Hb, AW, M, D}; pg8::StaticOrder S; S.init(AW, M, G, bid);
      pg8::EpiPlain E{VT, M, 1.0f};
      pg8::gemm_phase<pg8::EpiPlain, pg8::StaticOrder, true, true>(lds, g, S, E); }
    GRID_BAR();
    {
        LAS float* cw = (LAS float*)lds;
        for (int i = tid; i < CK * AW / 4; i += NTHREADS) *(LAS f32x4*)(cw + 4 * i) = *(const f32x4*)(in[12] + 4 * i);
        __syncthreads();
        const int gw = bid * NWAVES + wave, NGW = G * NWAVES; const int lane6 = FRESH_LANE();
#ifndef NO_CONV
        for (int grp = gw; grp < M / 4; grp += NGW) conv_group(grp, Ub, CAT, cw, in[13], in[14], in[15], lane6);
#endif
        for (int v = bid; v < BATCH * NHEAD * 8; v += G) { const int bh = v >> 3, qb0 = 32 * (v & 7);
#ifndef NO_ATTN
            for (int j = 0; j < 4; ++j) attn_unit(Qb, Kb, VT, CAT, in[11], bh / NHEAD, bh % NHEAD, qb0 + 8 * j + wave, lane6);
#endif
        }
    }
    GRID_BAR();
    { pg8::Gemm g{CAT, (const bf16*)(ws + WS_WMO), M, D, D}; pg8::StaticOrder S; S.init(M, D, G, bid);
      pg8::EpiPlain E{Yb, D, 1.0f};
      pg8::gemm_phase<pg8::EpiPlain, pg8::StaticOrder, true, true>(lds, g, S, E); }
    GRID_BAR();
    norm_pass<true, true>(args.out, Yb, args.out, Hb, MODV(1, 2), in[9], 1.0f, in[17], MODV(2, 1), MODV(2, 0), rowbeg, wave, FRESH_LANE());
    GRID_BAR();
    { pg8::Gemm g{Hb, (const bf16*)(ws + WS_W2IN), M, 2 * DFF, D}; pg8::StaticOrder S; S.init(M, 2 * DFF, G, bid);
      pg8::EpiSwiGLU E{ACT, DFF};
      pg8::gemm_phase<pg8::EpiSwiGLU, pg8::StaticOrder, true, true>(lds, g, S, E); }
    GRID_BAR();
    { pg8::Gemm g{ACT, (const bf16*)(ws + WS_W2OUT), M, D, DFF}; pg8::StaticOrder S; S.init(M, D, G, bid);
      pg8::EpiPlain E{Yb, D, 1.0f};
      pg8::gemm_phase<pg8::EpiPlain, pg8::StaticOrder, true, true>(lds, g, S, E); }
    GRID_BAR();
    norm_pass<true, false>(args.out, Yb, args.out, nullptr, MODV(2, 2), in[18], 0.5f, nullptr, nullptr, nullptr, rowbeg, wave, FRESH_LANE());
}

extern "C" void kernel_launch(void* const* d_in, const int* in_sizes, int n_in, void* d_out, int out_size, void* d_ws, size_t ws_size, hipStream_t stream) {
    static int grid = 0;
    if (grid == 0) {
        if (n_in != 21 || in_sizes[0] != M * D || out_size != M * D || ws_size < WS_END) { fprintf(stderr, "kernel_launch: unexpected problem geometry (n_in %d, ws %zu)\n", n_in, ws_size); grid = -1; return; }
        int dev = 0, cus = 0, per_cu = 0;
        hipGetDevice(&dev); hipDeviceGetAttribute(&cus, hipDeviceAttributeMultiprocessorCount, dev);
        if (hipFuncSetAttribute((const void*)fwd_megakernel, hipFuncAttributeMaxDynamicSharedMemorySize, LDS_BYTES) != hipSuccess) { fprintf(stderr, "kernel_launch: hipFuncSetAttribute failed\n"); grid = -1; return; }
        hipOccupancyMaxActiveBlocksPerMultiprocessor(&per_cu, (const void*)fwd_megakernel, NTHREADS, LDS_BYTES);
        (void)hipGetLastError();
        if (per_cu < 1 || cus != 256) fprintf(stderr, "kernel_launch: note: occupancy %d blocks/CU, %d CUs\n", per_cu, cus);
        grid = 256;
    }
    if (grid < 0) return;
    if (hipMemsetAsync((char*)d_ws + WS_CTL, 0, 16384, stream) != hipSuccess) { fprintf(stderr, "kernel_launch: memset failed\n"); return; }
    Args a{};
    for (int i = 0; i < 21; ++i) a.in[i] = (const float*)d_in[i];
    a.out = (float*)d_out; a.ws = (unsigned char*)d_ws;
    void* kargs[] = {&a};
    hipError_t e = hipLaunchCooperativeKernel((const void*)fwd_megakernel, dim3(grid), dim3(NTHREADS), kargs, LDS_BYTES, stream);
    if (e != hipSuccess) fprintf(stderr, "kernel_launch: cooperative launch failed: %s\n", hipGetErrorString(e));
}
```

```cpp
#include <hip/hip_runtime.h>
#include <hip/hip_cooperative_groups.h>
#include <cstdio>
#include <cstdint>
namespace cg = cooperative_groups;
#ifndef REP_ATTN
#define REP_ATTN 1
#endif
#ifndef REP_CONV
#define REP_CONV 1
#endif
#ifndef REP_P2
#define REP_P2 1
#endif
#ifndef REP_P4
#define REP_P4 1
#endif
#ifndef REP_P0
#define REP_P0 1
#endif
#ifndef REP_P3
#define REP_P3 1
#endif
namespace pg8 {
#define PG8_LAS __attribute__((address_space(3)))
typedef unsigned short bf16_t;
typedef short bf16x8 __attribute__((ext_vector_type(8)));
typedef float f32x4 __attribute__((ext_vector_type(4)));
typedef unsigned u32x4 __attribute__((ext_vector_type(4)));
constexpr int BM = 256, BK = 64, HALF = 128, HTB = HALF * BK * 2  , STAGE_BYTES = 8 * HTB, NXCD = 8, WGM = 8;

__host__ __device__ __forceinline__ int lds_byte(int r, int c) { const int st = (r >> 4) * 2 + (c >> 5), rr = r & 15, cc = c & 31, ob = rr * 64 + cc * 2; return st * 1024 + (ob ^ (((ob >> 9) & 1) << 5)); }
__host__ __device__ __forceinline__ void stage_rc(int b, int& R, int& C) { const int st = b / 1024, sb = b % 1024, swz = sb ^ (((sb >> 9) & 1) << 5); R = (st >> 1) * 16 + swz / 64; C = (st & 1) * 32 + (swz % 64) / 2; }
__host__ __device__ __forceinline__ int perm32(int rho) { const int n = rho >> 4, i = rho & 15; return 8 * (i >> 2) + 4 * n + (i & 3); }

struct Unit { int pm, pn; };
struct Gemm { const bf16_t* A; const bf16_t* Bt; int M, N, K; };

struct StaticOrder {
    int nM, nN, nwg, G, c;
    __host__ __device__ void init(int M, int N, int G_, int c_) { nM = M / BM; nN = N / BM; nwg = nM * nN; G = G_; c = c_; }
    __host__ __device__ bool next(int i, Unit& u) const {
        const long L = (long)i * G + c; if (L >= nwg) return false;
        int wgid = (int)L; { const int q = nwg / NXCD, r = nwg % NXCD, xcd = wgid % NXCD, off = wgid / NXCD; wgid = (xcd < r ? xcd * (q + 1) : r * (q + 1) + (xcd - r) * q) + off; }
        const int nig = WGM * nN, gid = wgid / nig, fm = gid * WGM, gsz = (nM - fm) < WGM ? (nM - fm) : WGM;
        u.pm = fm + ((wgid % nig) % gsz); u.pn = (wgid % nig) / gsz; return true;
    }
    __device__ __forceinline__ void a_ready(const Unit&) const {}
    __device__ __forceinline__ void done(const Unit&) const {}
};

__device__ __forceinline__ unsigned cvt_pk_bf16(float lo, float hi) { unsigned r; asm volatile("v_cvt_pk_bf16_f32 %0, %1, %2" : "=v"(r) : "v"(lo), "v"(hi)); return r; }
typedef float f32x2 __attribute__((ext_vector_type(2)));
__device__ __forceinline__ float fast_sigmoid(float v) { return __builtin_amdgcn_rcpf(1.0f + __builtin_amdgcn_exp2f(-1.4426950408889634f * v)); }
struct EpiPlain {
    static constexpr bool PERM = true, AFTER_DRAIN = false;
    bf16_t* O; int ldc; float scale;
    __device__ __forceinline__ void operator()(const f32x4 (&acc)[2][2][4][2], const Unit& u, int wr, int wc, int fr, int fq) const {
        const int row0 = u.pm * BM + wr * 64 + fr, col0 = u.pn * BM + wc * 32 + 8 * fq;
#pragma unroll
        for (int ai = 0; ai < 2; ++ai)
#pragma unroll
            for (int m = 0; m < 4; ++m) { bf16_t* rowp = O + (size_t)(row0 + ai * HALF + m * 16) * ldc + col0;
#pragma unroll
                for (int bj = 0; bj < 2; ++bj) { const f32x4 v0 = acc[ai][bj][m][0] * scale, v1 = acc[ai][bj][m][1] * scale;
                    u32x4 w; w.x = cvt_pk_bf16(v0[0], v0[1]); w.y = cvt_pk_bf16(v0[2], v0[3]); w.z = cvt_pk_bf16(v1[0], v1[1]); w.w = cvt_pk_bf16(v1[2], v1[3]);
                    *(u32x4*)(rowp + bj * HALF) = w; } }
    }
};
struct EpiSwiGLU {
    static constexpr bool PERM = true, AFTER_DRAIN = false;
    bf16_t* O; int ldc;
    __device__ __forceinline__ void operator()(const f32x4 (&acc)[2][2][4][2], const Unit& u, int wr, int wc, int fr, int fq) const {
        const int row0 = u.pm * BM + wr * 64 + fr, col0 = u.pn * HALF + wc * 32 + 8 * fq;
#pragma unroll
        for (int ai = 0; ai < 2; ++ai)
#pragma unroll
            for (int m = 0; m < 4; ++m) { bf16_t* rowp = O + (size_t)(row0 + ai * HALF + m * 16) * ldc + col0;
                f32x4 r[2];
#pragma unroll
                for (int n = 0; n < 2; ++n) { const f32x4 g = acc[ai][0][m][n], up = acc[ai][1][m][n];
#pragma unroll
                    for (int e = 0; e < 4; ++e) r[n][e] = g[e] * fast_sigmoid(g[e]) * up[e]; }
                u32x4 w; w.x = cvt_pk_bf16(r[0][0], r[0][1]); w.y = cvt_pk_bf16(r[0][2], r[0][3]); w.z = cvt_pk_bf16(r[1][0], r[1][1]); w.w = cvt_pk_bf16(r[1][2], r[1][3]);
                *(u32x4*)rowp = w; }
    }
};
struct EpiMix {
    static constexpr bool PERM = true, AFTER_DRAIN = false;
    bf16_t *Q, *Kb, *U;
    __device__ __forceinline__ void operator()(const f32x4 (&acc)[2][2][4][2], const Unit& u, int wr, int wc, int fr, int fq) const {
        const int row0 = u.pm * BM + wr * 64 + fr;
        if (u.pn < 4) {
            bf16_t* base = (u.pn < 2) ? Q : Kb; const float sc = (u.pn < 2) ? 0.125f : 1.0f; const int col0 = (u.pn & 1) * BM + wc * 32 + 8 * fq;
#pragma unroll
            for (int ai = 0; ai < 2; ++ai)
#pragma unroll
                for (int m = 0; m < 4; ++m) { bf16_t* rowp = base + (size_t)(row0 + ai * HALF + m * 16) * 512 + col0;
#pragma unroll
                    for (int bj = 0; bj < 2; ++bj) { const f32x4 v0 = acc[ai][bj][m][0] * sc, v1 = acc[ai][bj][m][1] * sc;
                        u32x4 w; w.x = cvt_pk_bf16(v0[0], v0[1]); w.y = cvt_pk_bf16(v0[2], v0[3]); w.z = cvt_pk_bf16(v1[0], v1[1]); w.w = cvt_pk_bf16(v1[2], v1[3]);
                        *(u32x4*)(rowp + bj * HALF) = w; } }
        } else {
            const int col0 = (u.pn - 4) * HALF + wc * 32 + 8 * fq;
#pragma unroll
            for (int ai = 0; ai < 2; ++ai)
#pragma unroll
                for (int m = 0; m < 4; ++m) { bf16_t* rowp = U + (size_t)(row0 + ai * HALF + m * 16) * 512 + col0;
                    f32x4 r[2];
#pragma unroll
                    for (int n = 0; n < 2; ++n) { const f32x4 cv = acc[ai][0][m][n], cgt = acc[ai][1][m][n];
#pragma unroll
                        for (int e = 0; e < 4; ++e) r[n][e] = cv[e] * fast_sigmoid(cgt[e]); }
                    u32x4 w; w.x = cvt_pk_bf16(r[0][0], r[0][1]); w.y = cvt_pk_bf16(r[0][2], r[0][3]); w.z = cvt_pk_bf16(r[1][0], r[1][1]); w.w = cvt_pk_bf16(r[1][2], r[1][3]);
                    *(u32x4*)rowp = w; }
        }
    }
};
template <class Epi, class Sched, bool ALIGN_EPI = false, bool SP2 = false>
__device__ __forceinline__ void gemm_phase(PG8_LAS unsigned char* lds, const Gemm g, const Sched& S, const Epi& E) {
    int tid_ = threadIdx.x; asm volatile("" : "+v"(tid_));
    const int tid = tid_, wid = __builtin_amdgcn_readfirstlane(tid >> 6), lane = tid & 63, wr = wid >> 2, wc = wid & 3, fr = lane & 15, fq = lane >> 4;
    const int K = g.K, nt = K / BK;
    unsigned voffA[2], voffB[2];
#pragma unroll
    for (int i = 0; i < 2; ++i) { int R, C; stage_rc(tid * 16 + i * 8192, R, C); const int Rb = Epi::PERM ? ((R & ~31) + perm32(R & 31)) : R;
        voffA[i] = (unsigned)(R * K + C) * 2u; voffB[i] = (unsigned)(Rb * K + C) * 2u; }
    const size_t kstep = (size_t)(BK * 2);
    const size_t hstep = (size_t)HALF * K * 2;
    const size_t tstep = 2 * hstep;
    const unsigned ldsw = (unsigned)wid * 1024u;
    const int aoff = lds_byte(wr * 64 + fr, fq * 8), boff = lds_byte(wc * 32 + fr, fq * 8);
#define PG8_SA(b, h) (((b) * 2 + (h)) * HTB)
#define PG8_SB(b, h) ((4 + (b) * 2 + (h)) * HTB)
#define PG8_STAGE(bufoff, gbase, voff) do { _Pragma("unroll") for (int _i = 0; _i < 2; ++_i) \
        __builtin_amdgcn_global_load_lds((const unsigned*)((const char*)(gbase) + (voff)[_i]), (PG8_LAS unsigned*)(lds + (bufoff) + ldsw + _i * 8192), 16, 0, 0); } while (0)
#define PG8_LDA(dst, b, h) do { _Pragma("unroll") for (int m = 0; m < 4; ++m) _Pragma("unroll") for (int k = 0; k < 2; ++k) dst[m][k] = *(const PG8_LAS bf16x8*)(lds + PG8_SA(b, h) + aoff + m * 2048 + k * 1024); } while (0)
#define PG8_LDB(dst, b, h) do { _Pragma("unroll") for (int n = 0; n < 2; ++n) _Pragma("unroll") for (int k = 0; k < 2; ++k) dst[n][k] = *(const PG8_LAS bf16x8*)(lds + PG8_SB(b, h) + boff + n * 2048 + k * 1024); } while (0)
#define PG8_MMA(ai, bj, At, Bt) do { __builtin_amdgcn_s_setprio(1); _Pragma("unroll") for (int m = 0; m < 4; ++m) _Pragma("unroll") for (int n = 0; n < 2; ++n) _Pragma("unroll") for (int k = 0; k < 2; ++k) \
        acc[ai][bj][m][n] = __builtin_amdgcn_mfma_f32_16x16x32_bf16(Bt[n][k], At[m][k], acc[ai][bj][m][n], 0, 0, 0); __builtin_amdgcn_s_setprio(0); } while (0)
#define PG8_WAIT_V(n) asm volatile("s_waitcnt vmcnt(" #n ")" ::: "memory")
#define PG8_WAIT_L(n) asm volatile("s_waitcnt lgkmcnt(" #n ")" ::: "memory")
#define PG8_BAR __builtin_amdgcn_s_barrier()
#define PG8_SCHED __builtin_amdgcn_sched_barrier(0)
    Unit cur, nxt; int ui = 0;
    if (!S.next(0, cur)) return;
    f32x4 acc[2][2][4][2];
#pragma unroll
    for (int a = 0; a < 2; ++a)
#pragma unroll
        for (int b = 0; b < 2; ++b)
#pragma unroll
            for (int m = 0; m < 4; ++m)
#pragma unroll
                for (int n = 0; n < 2; ++n) acc[a][b][m][n] = (f32x4){0.f, 0.f, 0.f, 0.f};
    bf16x8 At[4][2], B0[2][2], B1[2][2];
    const char* cA = (const char*)g.A + (size_t)cur.pm * tstep; const char* cB = (const char*)g.Bt + (size_t)cur.pn * tstep;
    S.a_ready(cur);
    if constexpr (SP2) {
        PG8_STAGE(PG8_SB(0, 0), cB, voffB); PG8_STAGE(PG8_SB(0, 1), cB + hstep, voffB); PG8_STAGE(PG8_SA(0, 0), cA, voffA); PG8_STAGE(PG8_SA(0, 1), cA + hstep, voffA);
        if (wr == 1) PG8_BAR;
        PG8_WAIT_V(2); PG8_BAR;
        PG8_STAGE(PG8_SB(1, 0), cB + kstep, voffB); PG8_STAGE(PG8_SA(1, 0), cA + kstep, voffA); PG8_STAGE(PG8_SB(1, 1), cB + hstep + kstep, voffB);
        PG8_WAIT_V(6); PG8_BAR;
    } else {
        PG8_STAGE(PG8_SB(0, 0), cB, voffB); PG8_STAGE(PG8_SA(0, 0), cA, voffA); PG8_STAGE(PG8_SB(0, 1), cB + hstep, voffB); PG8_STAGE(PG8_SA(0, 1), cA + hstep, voffA);
        if (wr == 1) PG8_BAR;
        PG8_WAIT_V(4); PG8_BAR;
        PG8_STAGE(PG8_SB(1, 0), cB + kstep, voffB); PG8_STAGE(PG8_SA(1, 0), cA + kstep, voffA); PG8_STAGE(PG8_SB(1, 1), cB + hstep + kstep, voffB);
        PG8_WAIT_V(6); PG8_BAR;
    }
    for (;;) {
        const bool has_next = S.next(ui + 1, nxt);
        const char* nA = has_next ? (const char*)g.A + (size_t)nxt.pm * tstep : cA; const char* nB = has_next ? (const char*)g.Bt + (size_t)nxt.pn * tstep : cB;
        for (int t = 0; t < nt; t += 2) {
            const bool last = (t == nt - 2);
            const char* a1 = cA + (size_t)(t + 1) * kstep;
            const char* a2 = last ? nA : cA + (size_t)(t + 2) * kstep; const char* b2 = last ? nB : cB + (size_t)(t + 2) * kstep;
            const char* a3 = a2 + kstep; const char* b3 = b2 + kstep;
            if (last && has_next) S.a_ready(nxt);
            if constexpr (SP2) {
            PG8_LDB(B0, 0, 0); PG8_LDB(B1, 0, 1); PG8_SCHED; PG8_LDA(At, 0, 0); PG8_STAGE(PG8_SA(1, 1), a1 + hstep, voffA);
            PG8_WAIT_V(8); PG8_WAIT_L(0); PG8_BAR; PG8_MMA(0, 0, At, B0); PG8_MMA(0, 1, At, B1); PG8_BAR; PG8_SCHED;
            PG8_LDA(At, 0, 1); PG8_STAGE(PG8_SB(0, 0), b2, voffB); PG8_STAGE(PG8_SB(0, 1), b2 + hstep, voffB); PG8_STAGE(PG8_SA(0, 0), a2, voffA);
            PG8_WAIT_V(8); PG8_WAIT_L(0); PG8_BAR; PG8_MMA(1, 0, At, B0); PG8_MMA(1, 1, At, B1); PG8_BAR; PG8_SCHED;
            PG8_LDB(B0, 1, 0); PG8_LDB(B1, 1, 1); PG8_SCHED; PG8_LDA(At, 1, 0); PG8_STAGE(PG8_SA(0, 1), a2 + hstep, voffA);
            PG8_WAIT_V(8); PG8_WAIT_L(0); PG8_BAR; PG8_MMA(0, 0, At, B0); PG8_MMA(0, 1, At, B1); PG8_BAR; PG8_SCHED;
            PG8_LDA(At, 1, 1); PG8_STAGE(PG8_SB(1, 0), b3, voffB); PG8_STAGE(PG8_SB(1, 1), b3 + hstep, voffB); PG8_STAGE(PG8_SA(1, 0), a3, voffA);
            PG8_WAIT_V(8); PG8_WAIT_L(0); PG8_BAR; PG8_MMA(1, 0, At, B0); PG8_MMA(1, 1, At, B1); PG8_BAR; PG8_SCHED;
            } else {
            PG8_LDB(B0, 0, 0); PG8_SCHED; PG8_LDA(At, 0, 0); PG8_STAGE(PG8_SA(1, 1), a1 + hstep, voffA);
            PG8_WAIT_L(8); PG8_BAR; PG8_WAIT_L(0); PG8_MMA(0, 0, At, B0); PG8_BAR; PG8_SCHED;
            PG8_LDB(B1, 0, 1); PG8_STAGE(PG8_SB(0, 0), b2, voffB);
            PG8_BAR; PG8_WAIT_L(0); PG8_MMA(0, 1, At, B1); PG8_BAR;
            PG8_LDA(At, 0, 1); PG8_STAGE(PG8_SA(0, 0), a2, voffA);
            PG8_BAR; PG8_WAIT_L(0); PG8_MMA(1, 0, At, B0); PG8_BAR; PG8_SCHED;
            PG8_STAGE(PG8_SB(0, 1), b2 + hstep, voffB);
            PG8_WAIT_V(6); PG8_BAR; PG8_MMA(1, 1, At, B1); PG8_BAR;
            PG8_LDB(B0, 1, 0); PG8_SCHED; PG8_LDA(At, 1, 0); PG8_STAGE(PG8_SA(0, 1), a2 + hstep, voffA);
            PG8_WAIT_L(8); PG8_BAR; PG8_WAIT_L(0); PG8_MMA(0, 0, At, B0); PG8_BAR; PG8_SCHED;
            PG8_LDB(B1, 1, 1); PG8_STAGE(PG8_SB(1, 0), b3, voffB);
            PG8_BAR; PG8_WAIT_L(0); PG8_MMA(0, 1, At, B1); PG8_BAR;
            PG8_LDA(At, 1, 1); PG8_STAGE(PG8_SA(1, 0), a3, voffA);
            PG8_BAR; PG8_WAIT_L(0); PG8_MMA(1, 0, At, B0); PG8_BAR; PG8_SCHED;
            PG8_STAGE(PG8_SB(1, 1), b3 + hstep, voffB);
            PG8_WAIT_V(6); PG8_BAR; PG8_MMA(1, 1, At, B1); PG8_BAR;
            }
        }
        if constexpr (ALIGN_EPI) { if (wr == 0) PG8_BAR; }
        if constexpr (!Epi::AFTER_DRAIN) { E(acc, cur, wr, wc, fr, fq); S.done(cur); }
        if (!has_next) break;
#pragma unroll
        for (int a = 0; a < 2; ++a)
#pragma unroll
            for (int b = 0; b < 2; ++b)
#pragma unroll
                for (int m = 0; m < 4; ++m)
#pragma unroll
                    for (int n = 0; n < 2; ++n) acc[a][b][m][n] = (f32x4){0.f, 0.f, 0.f, 0.f};
        cur = nxt; cA = nA; cB = nB; ++ui;
        if constexpr (ALIGN_EPI) { if (wr == 1) PG8_BAR; }
    }
    PG8_WAIT_V(0);
    if constexpr (!ALIGN_EPI) { if (wr == 0) PG8_BAR; }
    PG8_BAR;
    if constexpr (Epi::AFTER_DRAIN) { E.fused(acc, cur, wr, wc, fr, fq, lds, wid, lane); S.done(cur); }
#undef PG8_SA
#undef PG8_SB
#undef PG8_STAGE
#undef PG8_LDA
#undef PG8_LDB
#undef PG8_MMA
#undef PG8_WAIT_V
#undef PG8_WAIT_L
#undef PG8_BAR
#undef PG8_SCHED
}
}

constexpr int BATCH = 4, SEQ = 8192, D = 1024, M = BATCH * SEQ, DFF = 2816, AW = 512, NHEAD = 8, HD = 64, CK = 31, NMOD = 9 * D;
constexpr float RMS_EPS = 1e-6f, LN_EPS = 1e-5f;
constexpr int NWAVES = 8, NTHREADS = 512;
constexpr int LDS_BYTES = 147456;
constexpr int KCH = 16;
constexpr float STICK_EXIT = -110.0f;

constexpr size_t MiB = 1u << 20;
constexpr size_t WS_CTL = 0, WS_PART = 1 * MiB, WS_MODTAB = 4 * MiB;
constexpr size_t WS_W1IN = 8 * MiB, WS_W1OUT = 19 * MiB, WS_WMIXA = 25 * MiB, WS_WMIXV = 29 * MiB, WS_WMO = 30 * MiB, WS_W2IN = 32 * MiB, WS_W2OUT = 43 * MiB;
constexpr size_t WS_H = 64 * MiB, WS_Y = 128 * MiB, WS_ACT = 192 * MiB, WS_Q = 192 * MiB, WS_K = 224 * MiB, WS_VT = 256 * MiB, WS_U = 288 * MiB, WS_CAT = 368 * MiB, WS_END = 432 * MiB;

#define LAS __attribute__((address_space(3)))
typedef unsigned short bf16;
typedef float f32x4 __attribute__((ext_vector_type(4)));
typedef float f32x16 __attribute__((ext_vector_type(16)));
typedef short bf16x8 __attribute__((ext_vector_type(8)));
typedef short s16x4 __attribute__((ext_vector_type(4)));
typedef unsigned u32x2 __attribute__((ext_vector_type(2)));
typedef unsigned u32x4 __attribute__((ext_vector_type(4)));
typedef float f32x2_t __attribute__((ext_vector_type(2)));
typedef __bf16 bf16x2_t __attribute__((ext_vector_type(2)));
#define LDS_WAIT() asm volatile("s_waitcnt lgkmcnt(0)" ::: "memory")

__device__ __forceinline__ unsigned pk2(float lo, float hi) { f32x2_t v = {lo, hi}; bf16x2_t b = __builtin_convertvector(v, bf16x2_t); return __builtin_bit_cast(unsigned, b); }
__device__ __forceinline__ float bf_lo(unsigned u) { return __uint_as_float(u << 16); }
__device__ __forceinline__ float bf_hi(unsigned u) { return __uint_as_float(u & 0xffff0000u); }
__device__ __forceinline__ float wave_sum(float v) {
#pragma unroll
    for (int o = 1; o < 64; o <<= 1) v += __shfl_xor(v, o);
    return v;
}
__device__ __forceinline__ float rdlane(float v, int l) { return __uint_as_float((unsigned)__builtin_amdgcn_readlane((int)__float_as_uint(v), l)); }

__device__ __forceinline__ void tr_item(const float* __restrict__ W, int K, int N, bf16* dst, LAS float* scr, int k0, int n0, int lane) {
#pragma unroll 8
    for (int i = 0; i < 32; ++i) { const int kk = 2 * i + (lane >> 5); scr[kk * 33 + (lane & 31)] = W[(size_t)(k0 + kk) * N + n0 + (lane & 31)]; }
    LDS_WAIT(); asm volatile("" ::: "memory");
    const int c = lane & 7;
#pragma unroll
    for (int j = 0; j < 4; ++j) { const int n = (lane >> 3) + 8 * j; const LAS float* s = scr + (8 * c) * 33 + n;
        u32x4 o; o.x = pk2(s[0 * 33], s[1 * 33]); o.y = pk2(s[2 * 33], s[3 * 33]); o.z = pk2(s[4 * 33], s[5 * 33]); o.w = pk2(s[6 * 33], s[7 * 33]);
        *(u32x4*)(dst + (size_t)n * K + k0 + 8 * c) = o; }
    LDS_WAIT(); asm volatile("" ::: "memory");
}
__device__ __forceinline__ int ffin_row(int n0) { const int bj = n0 / DFF, c = n0 % DFF; return 256 * (c / 128) + 128 * bj + (c % 128); }
__device__ __forceinline__ void tr_matrix(int mat, int r, const float* const* in, unsigned char* ws, LAS float* scr, int lane) {
    if (mat == 0 || mat == 4) {
        const int nblk = 2 * DFF / 32, kb = r / nblk, nb = r % nblk, n0 = 32 * nb;
        bf16* dst = (bf16*)(ws + (mat == 0 ? WS_W1IN : WS_W2IN)) + (size_t)ffin_row(n0) * D;
        tr_item(in[mat == 0 ? 6 : 19], D, 2 * DFF, dst, scr, 64 * kb, n0, lane);
    } else if (mat == 1 || mat == 5) {
        const int nblk = D / 32, kb = r / nblk, nb = r % nblk, n0 = 32 * nb;
        bf16* dst = (bf16*)(ws + (mat == 1 ? WS_W1OUT : WS_W2OUT)) + (size_t)n0 * DFF;
        tr_item(in[mat == 1 ? 7 : 20], DFF, D, dst, scr, 64 * kb, n0, lane);
    } else if (mat == 2) {
        const int nblk = 2560 / 32, kb = r / nblk, nb = r % nblk, n0 = 32 * nb;
        bf16* dst;
        if (n0 < 1024) dst = (bf16*)(ws + WS_WMIXA) + (size_t)n0 * D;
        else if (n0 < 1536) dst = (bf16*)(ws + WS_WMIXV) + (size_t)(n0 - 1024) * D;
        else { const int c = n0 - 1536, bj = c / 512, cc = c % 512; dst = (bf16*)(ws + WS_WMIXA) + (size_t)(1024 + 256 * (cc / 128) + 128 * bj + (cc % 128)) * D; }
        tr_item(in[10], D, 2560, dst, scr, 64 * kb, n0, lane);
    } else {
        const int nblk = D / 32, kb = r / nblk, nb = r % nblk, n0 = 32 * nb;
        bf16* dst = (bf16*)(ws + WS_WMO) + (size_t)n0 * D;
        tr_item(in[16], D, D, dst, scr, 64 * kb, n0, lane);
    }
}
__device__ __forceinline__ void ada_item(int r, const float* __restrict__ cvec, const float* __restrict__ w_ada, float* part, int lane) {
    const int cgp = r / KCH, kc = r % KCH, n = 64 * cgp + lane;
    float sc[4], acc[4];
#pragma unroll
    for (int b = 0; b < 4; ++b) { const float v = cvec[b * D + 64 * kc + lane]; sc[b] = v / (1.0f + __expf(-v)); acc[b] = 0.f; }
    const float* wp = w_ada + (size_t)(64 * kc) * NMOD + n;
#pragma unroll
    for (int kk = 0; kk < 64; ++kk) { const float w = wp[(size_t)kk * NMOD];
#pragma unroll
        for (int b = 0; b < 4; ++b) acc[b] += rdlane(sc[b], kk) * w; }
#pragma unroll
    for (int b = 0; b < 4; ++b) part[(size_t)(kc * 4 + b) * NMOD + n] = acc[b];
}
__device__ __forceinline__ void p0_prologue(const float* const* in, unsigned char* ws, LAS unsigned char* lds, int wave, int lane) {
    LAS float* scr = (LAS float*)(lds + wave * 16384);
    const int gw = blockIdx.x * NWAVES + wave, NGW = gridDim.x * NWAVES;
    constexpr int I_IN = (D / 64) * (2 * DFF / 32), I_OUT = (DFF / 64) * (D / 32), I_MIX = (D / 64) * (2560 / 32), I_MO = (D / 64) * (D / 32);
    constexpr int NTR = 2 * I_IN + 2 * I_OUT + I_MIX + I_MO, NADA = (NMOD / 64) * KCH;
    for (int it = gw; it < NTR + NADA; it += NGW) {
        int r = it;
        if (r < I_IN) { tr_matrix(0, r, in, ws, scr, lane); continue; } r -= I_IN;
        if (r < I_OUT) { tr_matrix(1, r, in, ws, scr, lane); continue; } r -= I_OUT;
        if (r < I_MIX) { tr_matrix(2, r, in, ws, scr, lane); continue; } r -= I_MIX;
        if (r < I_MO) { tr_matrix(3, r, in, ws, scr, lane); continue; } r -= I_MO;
        if (r < I_IN) { tr_matrix(4, r, in, ws, scr, lane); continue; } r -= I_IN;
        if (r < I_OUT) { tr_matrix(5, r, in, ws, scr, lane); continue; } r -= I_OUT;
#ifndef NO_ADA
        ada_item(r, in[1], in[2], (float*)(ws + WS_PART), lane);
#endif
    }
}

template <bool HAS_Y, bool HAS_H>
__device__ __forceinline__ void norm_pass(const float* xin, const bf16* y, float* xout, bf16* h, const float* gate, const float* gpost, float rw,
                                          const float* gpre, const float* scale, const float* shift, int rowbeg, int wave, int lane) {
    f32x4 A[4], B[4], C[4];
#pragma unroll
    for (int j = 0; j < 4; ++j) { const int c = 4 * lane + 256 * j;
        if (HAS_Y) { const f32x4 g = *(const f32x4*)(gate + c), gp = *(const f32x4*)(gpost + c); A[j] = (g + 1.0f) * gp * rw; }
        if (HAS_H) { const f32x4 s = *(const f32x4*)(scale + c), gp = *(const f32x4*)(gpre + c); B[j] = (s + 1.0f) * gp; C[j] = *(const f32x4*)(shift + c); } }
    for (int i = 0; i < 16; ++i) {
        const size_t row = (size_t)(rowbeg + wave * 16 + i);
        f32x4 x[4]; u32x2 yv[4];
#pragma unroll
        for (int j = 0; j < 4; ++j) x[j] = *(const f32x4*)(xin + row * D + 4 * lane + 256 * j);
        if (HAS_Y) {
#pragma unroll
            for (int j = 0; j < 4; ++j) yv[j] = *(const u32x2*)(y + row * D + 4 * lane + 256 * j);
            f32x4 yf[4]; float ss = 0.f;
#pragma unroll
            for (int j = 0; j < 4; ++j) { yf[j] = (f32x4){bf_lo(yv[j].x), bf_hi(yv[j].x), bf_lo(yv[j].y), bf_hi(yv[j].y)}; ss += (yf[j].x * yf[j].x + yf[j].y * yf[j].y) + (yf[j].z * yf[j].z + yf[j].w * yf[j].w); }
            const float r = 1.0f / sqrtf(wave_sum(ss) * (1.0f / D) + RMS_EPS);
#pragma unroll
            for (int j = 0; j < 4; ++j) { x[j] = x[j] + A[j] * yf[j] * r; *(f32x4*)(xout + row * D + 4 * lane + 256 * j) = x[j]; }
        }
        if (HAS_H) {
            float ss = 0.f;
#pragma unroll
            for (int j = 0; j < 4; ++j) ss += (x[j].x * x[j].x + x[j].y * x[j].y) + (x[j].z * x[j].z + x[j].w * x[j].w);
            const float r = 1.0f / sqrtf(wave_sum(ss) * (1.0f / D) + RMS_EPS);
#pragma unroll
            for (int j = 0; j < 4; ++j) { const f32x4 o = x[j] * r * B[j] + C[j]; u32x2 w; w.x = pk2(o.x, o.y); w.y = pk2(o.z, o.w); *(u32x2*)(h + row * D + 4 * lane + 256 * j) = w; }
        }
    }
}

typedef float f32x2 __attribute__((ext_vector_type(2)));
__device__ __forceinline__ void conv_group(int grp, const bf16* U, bf16* cat, const LAS float* cw, const float* conv_b, const float* ln_g, const float* ln_b, int lane) {
    const int tok0 = grp * 4, s0 = tok0 % SEQ;
    f32x2 acc[4][4], w0[4], w1[4], w2[4], w3[4];
#pragma unroll
    for (int e = 0; e < 4; ++e) { w0[e] = (f32x2){0.f, 0.f}; w1[e] = w0[e]; w2[e] = w0[e]; w3[e] = w0[e];
#pragma unroll
        for (int i = 0; i < 4; ++i) acc[i][e] = (f32x2){0.f, 0.f}; }
    const bf16* up = U + (size_t)tok0 * AW + 8 * lane;
    const LAS float* cwl = cw + 8 * lane;
#define CONV_STEP(j, WA, WB, WC, WD) do { const int j_ = (j); \
        if (j_ < CK) { const f32x4 a_ = *(const LAS f32x4*)(cwl + j_ * AW), b_ = *(const LAS f32x4*)(cwl + j_ * AW + 4); \
            WA[0] = (f32x2){a_[0], a_[1]}; WA[1] = (f32x2){a_[2], a_[3]}; WA[2] = (f32x2){b_[0], b_[1]}; WA[3] = (f32x2){b_[2], b_[3]}; } \
        else { WA[0] = (f32x2){0.f, 0.f}; WA[1] = WA[0]; WA[2] = WA[0]; WA[3] = WA[0]; } \
        u32x4 v_ = (u32x4){0u, 0u, 0u, 0u}; \
        if (s0 - 30 + j_ >= 0 && j_ < 34) v_ = *(const u32x4*)(up + (ptrdiff_t)(j_ - 30) * AW); \
        const f32x2 x_[4] = {(f32x2){bf_lo(v_.x), bf_hi(v_.x)}, (f32x2){bf_lo(v_.y), bf_hi(v_.y)}, (f32x2){bf_lo(v_.z), bf_hi(v_.z)}, (f32x2){bf_lo(v_.w), bf_hi(v_.w)}}; \
        _Pragma("unroll") for (int e = 0; e < 4; ++e) { acc[0][e] += WA[e] * x_[e]; acc[1][e] += WB[e] * x_[e]; acc[2][e] += WC[e] * x_[e]; acc[3][e] += WD[e] * x_[e]; } } while (0)
#pragma unroll 1
    for (int j4 = 0; j4 < 36; j4 += 4) { CONV_STEP(j4, w0, w1, w2, w3); CONV_STEP(j4 + 1, w3, w0, w1, w2); CONV_STEP(j4 + 2, w2, w3, w0, w1); CONV_STEP(j4 + 3, w1, w2, w3, w0); }
#undef CONV_STEP
    const f32x4 b0 = *(const f32x4*)(conv_b + 8 * lane), b1 = *(const f32x4*)(conv_b + 8 * lane + 4);
    const f32x4 g0 = *(const f32x4*)(ln_g + 8 * lane), g1 = *(const f32x4*)(ln_g + 8 * lane + 4);
    const f32x4 lb0 = *(const f32x4*)(ln_b + 8 * lane), lb1 = *(const f32x4*)(ln_b + 8 * lane + 4);
#pragma unroll
    for (int i = 0; i < 4; ++i) {
        float v[8]; float s = 0.f;
#pragma unroll
        for (int e = 0; e < 8; ++e) { v[e] = acc[i][e >> 1][e & 1] + (e < 4 ? b0[e] : b1[e - 4]); s += v[e]; }
        const float mean = wave_sum(s) * (1.0f / AW); float q = 0.f;
#pragma unroll
        for (int e = 0; e < 8; ++e) { v[e] -= mean; q += v[e] * v[e]; }
        const float rstd = 1.0f / sqrtf(wave_sum(q) * (1.0f / AW) + LN_EPS);
        float o[8];
#pragma unroll
        for (int e = 0; e < 8; ++e) { const float t = v[e] * rstd * (e < 4 ? g0[e] : g1[e - 4]) + (e < 4 ? lb0[e] : lb1[e - 4]); o[e] = t * pg8::fast_sigmoid(t); }
        u32x4 w; w.x = pk2(o[0], o[1]); w.y = pk2(o[2], o[3]); w.z = pk2(o[4], o[5]); w.w = pk2(o[6], o[7]);
        *(u32x4*)(cat + (size_t)(tok0 + i) * D + AW + 8 * lane) = w;
    }
}

__device__ __forceinline__ int crow(int r, int hi) { return (r & 3) + 8 * (r >> 2) + 4 * hi; }
struct KVFrag { bf16x8 kf[4]; s16x4 va[2][2][2]; };
__device__ __forceinline__ void kv_load(KVFrag& f, const bf16* __restrict__ kp, const bf16* __restrict__ vp) {
#pragma unroll
    for (int d0 = 0; d0 < 4; ++d0) f.kf[d0] = *(const bf16x8*)(kp + 16 * d0);
#pragma unroll
    for (int db = 0; db < 2; ++db)
#pragma unroll
        for (int ks = 0; ks < 2; ++ks) { f.va[db][ks][0] = *(const s16x4*)(vp + (size_t)db * 32 * M + 16 * ks); f.va[db][ks][1] = *(const s16x4*)(vp + (size_t)db * 32 * M + 16 * ks + 8); }
}
template <bool DIAG>
__device__ __forceinline__ void attn_tile(const KVFrag& f, const bf16x8 (&qf)[4], f32x16& o0, f32x16& o1, float& carry, int r32, int hi) {
    f32x16 p;
#pragma unroll
    for (int r = 0; r < 16; ++r) p[r] = 0.f;
#pragma unroll
    for (int d0 = 0; d0 < 4; ++d0) p = __builtin_amdgcn_mfma_f32_32x32x16_bf16(f.kf[d0], qf[d0], p, 0, 0, 0);
    float L[16];
#pragma unroll
    for (int r = 0; r < 16; ++r) { const float z = p[r];
        const float sp = fmaxf(z, 0.f) + 0.6931471805599453f * __builtin_amdgcn_logf(1.0f + __builtin_amdgcn_exp2f(-1.4426950408889634f * fabsf(z)));
        L[r] = (!DIAG || (crow(r, hi) < r32)) ? -sp : 0.f; }
    float E[4], O[4];
#pragma unroll
    for (int c = 0; c < 4; ++c) { const float gs = (L[4 * c] + L[4 * c + 1]) + (L[4 * c + 2] + L[4 * c + 3]);
        auto rr = __builtin_amdgcn_permlane32_swap(__float_as_uint(gs), __float_as_uint(gs), false, false);
        E[c] = __uint_as_float(rr[0]); O[c] = __uint_as_float(rr[1]); }
    float T[4]; T[3] = 0.f; T[2] = E[3] + O[3]; T[1] = T[2] + (E[2] + O[2]); T[0] = T[1] + (E[1] + O[1]);
    const float total = T[0] + (E[0] + O[0]);
    float w[16];
#pragma unroll
    for (int c = 0; c < 4; ++c) {
        const float after = carry + T[c] + (hi == 0 ? O[c] : 0.f);
        const float s3 = L[4 * c + 3] + after, s2 = L[4 * c + 2] + s3, s1 = L[4 * c + 1] + s2, s0_ = L[4 * c] + s1;
        const float ss[4] = {s0_, s1, s2, s3};
#pragma unroll
        for (int i = 0; i < 4; ++i) { const int r = 4 * c + i;
            const float e = __builtin_amdgcn_exp2f(1.4426950408889634f * (p[r] + ss[i]));
            w[r] = (!DIAG || (crow(r, hi) < r32)) ? e : 0.f; }
    }
    carry += total;
#pragma unroll
    for (int ks = 0; ks < 2; ++ks) {
        u32x4 pw; pw.x = pk2(w[8 * ks], w[8 * ks + 1]); pw.y = pk2(w[8 * ks + 2], w[8 * ks + 3]); pw.z = pk2(w[8 * ks + 4], w[8 * ks + 5]); pw.w = pk2(w[8 * ks + 6], w[8 * ks + 7]);
        const bf16x8 pb = __builtin_bit_cast(bf16x8, pw);
        const bf16x8 a0 = __builtin_shufflevector(f.va[0][ks][0], f.va[0][ks][1], 0, 1, 2, 3, 4, 5, 6, 7);
        const bf16x8 a1 = __builtin_shufflevector(f.va[1][ks][0], f.va[1][ks][1], 0, 1, 2, 3, 4, 5, 6, 7);
        o0 = __builtin_amdgcn_mfma_f32_32x32x16_bf16(a0, pb, o0, 0, 0, 0);
        o1 = __builtin_amdgcn_mfma_f32_32x32x16_bf16(a1, pb, o1, 0, 0, 0);
    }
}
__device__ __forceinline__ void attn_unit(const bf16* __restrict__ Q, const bf16* __restrict__ K, const bf16* __restrict__ VT, bf16* cat, const float* __restrict__ g_attn, int b, int h, int qb, int lane) {
    const int r32 = lane & 31, hi = lane >> 5;
    const size_t rowbase = (size_t)b * SEQ;
    const int t0 = qb * 32;
    const bf16* kp = K + (rowbase + t0 + r32) * AW + h * HD + 8 * hi;
    const bf16* vp = VT + (size_t)(h * HD + r32) * M + rowbase + t0 + 4 * hi;
    KVFrag fa, fb;
    kv_load(fa, kp, vp);
    bf16x8 qf[4];
    { const bf16* qp = Q + (rowbase + t0 + r32) * AW + h * HD + 8 * hi;
#pragma unroll
      for (int d0 = 0; d0 < 4; ++d0) qf[d0] = *(const bf16x8*)(qp + 16 * d0); }
    f32x16 o0, o1;
#pragma unroll
    for (int r = 0; r < 16; ++r) { o0[r] = 0.f; o1[r] = 0.f; }
    float carry = 0.f;
    int kb = qb;
    { const int nb = kb > 0 ? 1 : 0; kv_load(fb, kp - (ptrdiff_t)nb * 32 * AW, vp - nb * 32); }
    attn_tile<true>(fa, qf, o0, o1, carry, r32, hi);
    while (kb > 0 && !__all(carry < STICK_EXIT)) {
        --kb;
        { const int nb = kb > 0 ? kb - 1 : 0; const ptrdiff_t back = (ptrdiff_t)(qb - nb) * 32; kv_load(fa, kp - back * AW, vp - back); }
        attn_tile<false>(fb, qf, o0, o1, carry, r32, hi);
        if (kb == 0 || __all(carry < STICK_EXIT)) break;
        --kb;
        { const int nb = kb > 0 ? kb - 1 : 0; const ptrdiff_t back = (ptrdiff_t)(qb - nb) * 32; kv_load(fb, kp - back * AW, vp - back); }
        attn_tile<false>(fa, qf, o0, o1, carry, r32, hi);
    }
    float ss = 0.f;
#pragma unroll
    for (int r = 0; r < 16; ++r) ss += o0[r] * o0[r] + o1[r] * o1[r];
    { auto rr = __builtin_amdgcn_permlane32_swap(__float_as_uint(ss), __float_as_uint(ss), false, false); ss = __uint_as_float(rr[0]) + __uint_as_float(rr[1]); }
    const float rstd = 1.0f / sqrtf(ss * (1.0f / HD) + RMS_EPS);
    bf16* op = cat + (rowbase + t0 + r32) * D + h * HD + 4 * hi;
    const float* gp = g_attn + h * HD + 4 * hi;
#pragma unroll
    for (int c = 0; c < 4; ++c) {
        const f32x4 ga = *(const f32x4*)(gp + 8 * c), gb = *(const f32x4*)(gp + 32 + 8 * c);
        u32x2 wa, wb;
        wa.x = pk2(o0[4 * c] * rstd * ga.x, o0[4 * c + 1] * rstd * ga.y); wa.y = pk2(o0[4 * c + 2] * rstd * ga.z, o0[4 * c + 3] * rstd * ga.w);
        wb.x = pk2(o1[4 * c] * rstd * gb.x, o1[4 * c + 1] * rstd * gb.y); wb.y = pk2(o1[4 * c + 2] * rstd * gb.z, o1[4 * c + 3] * rstd * gb.w);
        *(u32x2*)(op + 8 * c) = wa; *(u32x2*)(op + 32 + 8 * c) = wb;
    }
}

#define XB_TMO      128
#define XB_XCNT(j)  (256  + 64 * (j))
#define XB_XSUB(j)  (1280 + 64 * (j))
#define XB_XGEN(j)  (2304 + 64 * (j))
#define XB_TOP      3328
#define XB_TOPGEN   3392
#define XCD_BAR_WORDS 3456
#define XB_SPIN_CAP (1u << 18)

__device__ __forceinline__ unsigned xb_ld(unsigned* p)              { return __hip_atomic_load(p, __ATOMIC_RELAXED, __HIP_MEMORY_SCOPE_AGENT); }
__device__ __forceinline__ unsigned xb_add(unsigned* p, unsigned v) { return __hip_atomic_fetch_add(p, v, __ATOMIC_RELAXED, __HIP_MEMORY_SCOPE_AGENT); }
__device__ __forceinline__ unsigned xb_xcc_id() { return (unsigned)__builtin_amdgcn_s_getreg((3 << 11) | 20) & 0xFu; }
#define XB_SPIN(cond, bar) do { unsigned _sp = 0; while (cond) { __builtin_amdgcn_s_sleep(1); \
    if ((++_sp & 255u) == 0u) { if (xb_ld(&(bar)[XB_TMO])) break; if (_sp > XB_SPIN_CAP) { atomicAdd(&(bar)[XB_TMO], 1u); break; } } } } while (0)

struct XcdBarrier {
    unsigned* bar; unsigned x;
    volatile LAS unsigned* st;
};

__device__ __forceinline__ XcdBarrier xcd_barrier_post(unsigned* bar, volatile LAS unsigned* st) {
    XcdBarrier b; b.bar = bar; b.x = xb_xcc_id(); b.st = st;
    if (threadIdx.x == 0) (void)xb_add(&bar[XB_XCNT(b.x)], 1u);
    return b;
}
__device__ __forceinline__ void xcd_barrier_complete(unsigned* bar, unsigned x, unsigned& nloc, unsigned& nx) {
    const unsigned G = gridDim.x * gridDim.y * gridDim.z;
    unsigned sum, cnt, mine, sp = 0u;
    for (;;) {
        sum = 0u; cnt = 0u; mine = 0u;
#pragma unroll
        for (unsigned j = 0; j < 16; ++j) { const unsigned c = xb_ld(&bar[XB_XCNT(j)]); sum += c; cnt += (c > 0u) ? 1u : 0u; mine = (j == x) ? c : mine; }
        if (sum == G) break;
        __builtin_amdgcn_s_sleep(1);
        if ((++sp & 255u) == 0u) { if (xb_ld(&bar[XB_TMO])) break; if (sp > XB_SPIN_CAP) { atomicAdd(&bar[XB_TMO], 1u); break; } }
    }
    nloc = mine > 0u ? mine : 1u; nx = cnt > 0u ? cnt : 1u;
}

__device__ __forceinline__ void xcd_barrier(const XcdBarrier& b) {
    asm volatile("s_waitcnt vmcnt(0)" ::: "memory");
    __syncthreads();
    if (threadIdx.x == 0) {
        unsigned* bar = b.bar;
        __builtin_amdgcn_s_waitcnt(0);
        unsigned nloc = b.st[0], nx = b.st[1];
        if (nloc == 0u) { xcd_barrier_complete(bar, b.x, nloc, nx); b.st[0] = nloc; b.st[1] = nx; }
        const unsigned old = xb_add(&bar[XB_XSUB(b.x)], 1u);
        const unsigned gen = old / nloc;
        if (old + 1u == (gen + 1u) * nloc) {
            __builtin_amdgcn_fence(__ATOMIC_RELEASE, "agent");
            asm volatile("s_waitcnt vmcnt(0)" ::: "memory");
            const unsigned og = xb_add(&bar[XB_TOP], 1u);
            const unsigned tg = og / nx;
            if (og + 1u == (tg + 1u) * nx) xb_add(&bar[XB_TOPGEN], 1u);
            else XB_SPIN(xb_ld(&bar[XB_TOPGEN]) == tg, bar);
            __builtin_amdgcn_fence(__ATOMIC_ACQUIRE, "agent");
            xb_add(&bar[XB_XGEN(b.x)], 1u);
            asm volatile("s_waitcnt vmcnt(0)" ::: "memory");
        } else {
            XB_SPIN(xb_ld(&bar[XB_XGEN(b.x)]) == gen, bar);
            __builtin_amdgcn_fence(__ATOMIC_ACQUIRE, "agent");
            asm volatile("s_waitcnt vmcnt(0)" ::: "memory");
        }
    }
    __syncthreads();
}

struct Args { const float* in[21]; float* out; unsigned char* ws; };
__global__ void __launch_bounds__(NTHREADS, 2) fwd_megakernel(Args args) {
    extern __shared__ __attribute__((aligned(16))) unsigned char lds_raw[];
    LAS unsigned char* lds = (LAS unsigned char*)lds_raw;
    cg::grid_group grid = cg::this_grid();
    const int tid = threadIdx.x, lane = tid & 63, wave = __builtin_amdgcn_readfirstlane(tid >> 6);
    const int G = gridDim.x, bid = blockIdx.x;
    unsigned char* ws = args.ws;
    const float* const* in = args.in;
    bf16* Hb = (bf16*)(ws + WS_H); bf16* Yb = (bf16*)(ws + WS_Y); bf16* ACT = (bf16*)(ws + WS_ACT);
    bf16* Qb = (bf16*)(ws + WS_Q); bf16* Kb = (bf16*)(ws + WS_K); bf16* VT = (bf16*)(ws + WS_VT); bf16* Ub = (bf16*)(ws + WS_U); bf16* CAT = (bf16*)(ws + WS_CAT);
    float* part = (float*)(ws + WS_PART); float* modtab = (float*)(ws + WS_MODTAB);
    for (int u = tid; u < (LDS_BYTES - 131072) / 4; u += NTHREADS) ((LAS unsigned*)(lds + 131072))[u] = 0u;
    __syncthreads();
    XcdBarrier bar = xcd_barrier_post((unsigned*)(ws + WS_CTL), (volatile LAS unsigned*)(lds + 131072 + 64));
    const int rowbeg = bid * (M / 256), batch = rowbeg / SEQ;
#define GRID_BAR() xcd_barrier(bar)
#define FRESH_LANE() ({ int l_ = lane; asm volatile("" : "+v"(l_)); l_; })
#define MODV(sub, j) (modtab + ((size_t)batch * 9 + (sub) * 3 + (j)) * D)

    for (int rep = 0; rep < REP_P0; ++rep)
    p0_prologue(in, ws, lds, wave, FRESH_LANE());
    grid.sync();

    {
        if (tid < 36) { const int f4 = bid * 36 + tid;
            const int bb = f4 / (NMOD / 4), off = (f4 % (NMOD / 4)) * 4;
            f32x4 s = *(const f32x4*)(in[3] + off);
#pragma unroll
            for (int kc = 0; kc < KCH; ++kc) s = s + *(const f32x4*)(part + (size_t)(kc * 4 + bb) * NMOD + off);
            *(f32x4*)(modtab + (size_t)bb * NMOD + off) = s; }
        LAS float* ml = (LAS float*)lds;
        { const int off = tid * 4; f32x4 s = *(const f32x4*)(in[3] + off);
#pragma unroll
          for (int kc = 0; kc < KCH; ++kc) s = s + *(const f32x4*)(part + (size_t)(kc * 4 + batch) * NMOD + off);
          *(LAS f32x4*)(ml + off) = s; }
        __syncthreads();
        norm_pass<false, true>(in[0], nullptr, nullptr, Hb, nullptr, nullptr, 0.f, in[4], (const float*)(ml + D), (const float*)ml, rowbeg, wave, FRESH_LANE());
    }
    GRID_BAR();

    for (int rep = 0; rep < REP_P2; ++rep)
    { pg8::Gemm g{Hb, (const bf16*)(ws + WS_W1IN), M, 2 * DFF, D}; pg8::StaticOrder S; S.init(M, 2 * DFF, G, bid);
      pg8::EpiSwiGLU E{ACT, DFF};
      pg8::gemm_phase<pg8::EpiSwiGLU, pg8::StaticOrder, true, true>(lds, g, S, E); }
    GRID_BAR();
    for (int rep = 0; rep < REP_P3; ++rep)
    { pg8::Gemm g{ACT, (const bf16*)(ws + WS_W1OUT), M, D, DFF}; pg8::StaticOrder S; S.init(M, D, G, bid);
      pg8::EpiPlain E{Yb, D, 1.0f};
      pg8::gemm_phase<pg8::EpiPlain, pg8::StaticOrder, true, true>(lds, g, S, E); }
    GRID_BAR();
    for (int rep = 0; rep < REP_P4; ++rep)
    norm_pass<true, true>(in[0], Yb, args.out, Hb, MODV(0, 2), in[5], 0.5f, in[8], MODV(1, 1), MODV(1, 0), rowbeg, wave, FRESH_LANE());
    GRID_BAR();
    { pg8::Gemm g{Hb, (const bf16*)(ws + WS_WMIXA), M, 2048, D}; pg8::StaticOrder S; S.init(M, 2048, G, bid);
      pg8::EpiMix E{Qb, Kb, Ub};
      pg8::gemm_phase<pg8::EpiMix, pg8::StaticOrder, true, true>(lds, g, S, E); }
    { pg8::Gemm g{(const bf16*)(ws + WS_WMIXV), Hb, AW, M, D}; pg8::StaticOrder S; S.init(AW, M, G, bid);
      pg8::EpiPlain E{VT, M, 1.0f};
      pg8::gemm_phase<pg8::EpiPlain, pg8::StaticOrder, true, true>(lds, g, S, E); }
    GRID_BAR();
    {
        LAS float* cw = (LAS float*)lds;
        for (int i = tid; i < CK * AW / 4; i += NTHREADS) *(LAS f32x4*)(cw + 4 * i) = *(const f32x4*)(in[12] + 4 * i);
        __syncthreads();
        const int gw = bid * NWAVES + wave, NGW = G * NWAVES; const int lane6 = FRESH_LANE();
        const int bh = bid >> 3, qb0 = 32 * (bid & 7);
        for (int rep = 0; rep < REP_ATTN; ++rep)
        for (int st = 0; st < 8; ++st) {
            const int j = st >> 1; const bool do_attn = ((st & 1) == 0) == (wave < 4);
            if (do_attn) attn_unit(Qb, Kb, VT, CAT, in[11], bh / NHEAD, bh % NHEAD, qb0 + 8 * j + wave, lane6);
            else conv_group(gw + j * NGW, Ub, CAT, cw, in[13], in[14], in[15], lane6);
        }
    }
    GRID_BAR();
    { pg8::Gemm g{CAT, (const bf16*)(ws + WS_WMO), M, D, D}; pg8::StaticOrder S; S.init(M, D, G, bid);
      pg8::EpiPlain E{Yb, D, 1.0f};
      pg8::gemm_phase<pg8::EpiPlain, pg8::StaticOrder, true, true>(lds, g, S, E); }
    GRID_BAR();
    norm_pass<true, true>(args.out, Yb, args.out, Hb, MODV(1, 2), in[9], 1.0f, in[17], MODV(2, 1), MODV(2, 0), rowbeg, wave, FRESH_LANE());
    GRID_BAR();
    { pg8::Gemm g{Hb, (const bf16*)(ws + WS_W2IN), M, 2 * DFF, D}; pg8::StaticOrder S; S.init(M, 2 * DFF, G, bid);
      pg8::EpiSwiGLU E{ACT, DFF};
      pg8::gemm_phase<pg8::EpiSwiGLU, pg8::StaticOrder, true, true>(lds, g, S, E); }
    GRID_BAR();
    { pg8::Gemm g{ACT, (const bf16*)(ws + WS_W2OUT), M, D, DFF}; pg8::StaticOrder S; S.init(M, D, G, bid);
      pg8::EpiPlain E{Yb, D, 1.0f};
      pg8::gemm_phase<pg8::EpiPlain, pg8::StaticOrder, true, true>(lds, g, S, E); }
    GRID_BAR();
    norm_pass<true, false>(args.out, Yb, args.out, nullptr, MODV(2, 2), in[18], 0.5f, nullptr, nullptr, nullptr, rowbeg, wave, FRESH_LANE());
}

extern "C" void kernel_launch(void* const* d_in, const int* in_sizes, int n_in, void* d_out, int out_size, void* d_ws, size_t ws_size, hipStream_t stream) {
    static int grid = 0;
    if (grid == 0) {
        if (n_in != 21 || in_sizes[0] != M * D || out_size != M * D || ws_size < WS_END) { fprintf(stderr, "kernel_launch: unexpected problem geometry (n_in %d, ws %zu)\n", n_in, ws_size); grid = -1; return; }
        int dev = 0, cus = 0, per_cu = 0;
        hipGetDevice(&dev); hipDeviceGetAttribute(&cus, hipDeviceAttributeMultiprocessorCount, dev);
        if (hipFuncSetAttribute((const void*)fwd_megakernel, hipFuncAttributeMaxDynamicSharedMemorySize, LDS_BYTES) != hipSuccess) { fprintf(stderr, "kernel_launch: hipFuncSetAttribute failed\n"); grid = -1; return; }
        hipOccupancyMaxActiveBlocksPerMultiprocessor(&per_cu, (const void*)fwd_megakernel, NTHREADS, LDS_BYTES);
        (void)hipGetLastError();
        if (per_cu < 1 || cus != 256) fprintf(stderr, "kernel_launch: note: occupancy %d blocks/CU, %d CUs\n", per_cu, cus);
        grid = 256;
    }
    if (grid < 0) return;
    if (hipMemsetAsync((char*)d_ws + WS_CTL, 0, 16384, stream) != hipSuccess) { fprintf(stderr, "kernel_launch: memset failed\n"); return; }
    Args a{};
    for (int i = 0; i < 21; ++i) a.in[i] = (const float*)d_in[i];
    a.out = (float*)d_out; a.ws = (unsigned char*)d_ws;
    void* kargs[] = {&a};
    hipError_t e = hipLaunchCooperativeKernel((const void*)fwd_megakernel, dim3(grid), dim3(NTHREADS), kargs, LDS_BYTES, stream);
    if (e != hipSuccess) fprintf(stderr, "kernel_launch: cooperative launch failed: %s\n", hipGetErrorString(e));
}
```
